# Optimizing an MI355X kernel written in HIP

```python
import jax, jax.numpy as jnp
from jax import lax
import numpy as np

D_MODEL = 1024
BATCH = 8
SEQ = 2048
DEPTH = 2
DEC_BATCH = 128
DEC_SEQ = 4
PAST_LEN = 16384
PAGE_SIZE = 128

C_A = D_MODEL
C_B = (3 * D_MODEL) // 2
CONV_WIDTH = 31
CHUNK = 128
N_GROUPS = 8
GROUP_DIM = C_B // N_GROUPS
D_FF = 4 * D_MODEL
P_DIM = 256
D_IN = 2 * C_A + 2 * C_B + 2 * D_MODEL
EPS = 1e-6

kernel_name = "gated_conformer_gmlp_decoder_step"


def _rmsnorm(x, g):
    xf = x.astype(jnp.float32)
    y = xf * lax.rsqrt(jnp.mean(xf * xf, axis=-1, keepdims=True) + EPS)
    return (y * g.astype(jnp.float32)).astype(x.dtype)


def _layernorm(x, g, b):
    xf = x.astype(jnp.float32)
    mu = jnp.mean(xf, axis=-1, keepdims=True)
    xc = xf - mu
    y = xc * lax.rsqrt(jnp.mean(xc * xc, axis=-1, keepdims=True) + EPS)
    return (y * g.astype(jnp.float32) + b.astype(jnp.float32)).astype(x.dtype)


def _depthwise_causal_conv(x_full, w, b):
    y = lax.conv_general_dilated(
        x_full, w[:, None, :], window_strides=(1,), padding='VALID',
        dimension_numbers=('NWC', 'WIO', 'NWC'), feature_group_count=x_full.shape[-1])
    return y + b


def _chunk_spatial_mix(v, w_s, b_s):
    bsz, t_len, _ = v.shape
    n_chunks = -(-t_len // CHUNK)
    pad = n_chunks * CHUNK - t_len
    vp = jnp.pad(v, ((0, 0), (0, pad), (0, 0))).reshape(bsz, n_chunks, CHUNK, N_GROUPS, GROUP_DIM)
    causal = jnp.tril(jnp.ones((CHUNK, CHUNK), dtype=bool))
    wm = jnp.where(causal[None], w_s, jnp.zeros_like(w_s))
    mixed = jnp.einsum('gts,bnsgc->bntgc', wm, vp) + jnp.transpose(b_s)[None, None, :, :, None]
    return mixed.reshape(bsz, n_chunks * CHUNK, C_B)[:, :t_len]


def _layer(x, conv_prev, p_l, g_mix, w_in, b_in, conv_w, conv_b, ln_a_g, ln_a_b, w_a_out,
           ln_v_g, ln_v_b, w_s, b_s, w_b_out, w_o, g_ffn, w_ff1, w_ff2,
           g_ple, w_ple, w_ple_gate, b_ple_gate):
    h = _rmsnorm(x, g_mix)
    z = h @ w_in + b_in
    a_lin = z[..., :C_A]
    a_gate = z[..., C_A:2 * C_A]
    zb = z[..., 2 * C_A:2 * C_A + 2 * C_B]
    g_a = z[..., 2 * C_A + 2 * C_B:2 * C_A + 2 * C_B + D_MODEL]
    g_b = z[..., 2 * C_A + 2 * C_B + D_MODEL:]
    glu = a_lin * jax.nn.sigmoid(a_gate)
    conv_in = jnp.concatenate([conv_prev, glu], axis=1)
    ya = _depthwise_causal_conv(conv_in, conv_w, conv_b)
    ya = jax.nn.silu(_layernorm(ya, ln_a_g, ln_a_b)) @ w_a_out
    new_conv = conv_in[:, -(CONV_WIDTH - 1):]
    zb = jax.nn.gelu(zb)
    u = zb[..., :C_B]
    v = _layernorm(zb[..., C_B:], ln_v_g, ln_v_b)
    yb = (u * _chunk_spatial_mix(v, w_s, b_s)) @ w_b_out
    m = jax.nn.sigmoid(g_a) * ya + jax.nn.sigmoid(g_b) * yb
    x = x + m @ w_o
    hf = _rmsnorm(x, g_ffn)
    x = x + jnp.square(jax.nn.relu(hf @ w_ff1)) @ w_ff2
    gate = jax.nn.sigmoid(_rmsnorm(x, g_ple) @ w_ple_gate + b_ple_gate)
    x = x + gate * (p_l @ w_ple)
    t_len = x.shape[1]
    start = ((t_len - 1) // CHUNK) * CHUNK
    return x, new_conv, v[:, start:]


def setup_inputs(seed: int = 0) -> dict:
    key = jax.random.key(seed)
    ks = jax.random.split(key, 32)

    def nrm(k, shape, scale):
        return (jax.random.normal(k, shape, dtype=jnp.float32) * scale).astype(jnp.float32)

    def gain(k, shape):
        return 1.0 + nrm(k, shape, 0.05)

    L = DEPTH
    return {
        "x_prompt": nrm(ks[0], (BATCH, SEQ, D_MODEL), 1.0),
        "x_sample": nrm(ks[1], (DEC_BATCH, DEC_SEQ, D_MODEL), 1.0),
        "state_conv": nrm(ks[2], (L, DEC_BATCH, CONV_WIDTH - 1, C_A), 0.5),
        "p_prompt": nrm(ks[3], (L, BATCH, SEQ, P_DIM), 1.0),
        "p_sample": nrm(ks[4], (L, DEC_BATCH, DEC_SEQ, P_DIM), 1.0),
        "g_mix": gain(ks[5], (L, D_MODEL)),
        "w_in": nrm(ks[6], (L, D_MODEL, D_IN), D_MODEL ** -0.5),
        "b_in": nrm(ks[7], (L, D_IN), 0.02),
        "conv_w": nrm(ks[8], (L, CONV_WIDTH, C_A), CONV_WIDTH ** -0.5),
        "conv_b": nrm(ks[9], (L, C_A), 0.02),
        "ln_a_g": gain(ks[10], (L, C_A)),
        "ln_a_b": nrm(ks[11], (L, C_A), 0.02),
        "w_a_out": nrm(ks[12], (L, C_A, D_MODEL), C_A ** -0.5),
        "ln_v_g": gain(ks[13], (L, C_B)),
        "ln_v_b": nrm(ks[14], (L, C_B), 0.02),
        "w_s": nrm(ks[15], (L, N_GROUPS, CHUNK, CHUNK), CHUNK ** -0.5),
        "b_s": 1.0 + nrm(ks[16], (L, N_GROUPS, CHUNK), 0.1),
        "w_b_out": nrm(ks[17], (L, C_B, D_MODEL), C_B ** -0.5),
        "w_o": nrm(ks[18], (L, D_MODEL, D_MODEL), D_MODEL ** -0.5),
        "g_ffn": gain(ks[19], (L, D_MODEL)),
        "w_ff1": nrm(ks[20], (L, D_MODEL, D_FF), D_MODEL ** -0.5),
        "w_ff2": nrm(ks[21], (L, D_FF, D_MODEL), D_FF ** -0.5),
        "g_ple": gain(ks[22], (L, D_MODEL)),
        "w_ple": nrm(ks[23], (L, P_DIM, D_MODEL), P_DIM ** -0.5),
        "w_ple_gate": nrm(ks[24], (L, D_MODEL, D_MODEL), D_MODEL ** -0.5),
        "b_ple_gate": nrm(ks[25], (L, D_MODEL), 0.02),
        "g_final": gain(ks[26], (D_MODEL,)),
    }


def reference(x_prompt, x_sample, state_conv, p_prompt, p_sample,
              g_mix, w_in, b_in, conv_w, conv_b, ln_a_g, ln_a_b, w_a_out,
              ln_v_g, ln_v_b, w_s, b_s, w_b_out, w_o, g_ffn, w_ff1, w_ff2,
              g_ple, w_ple, w_ple_gate, b_ple_gate, g_final):
    xp = x_prompt
    xs = x_sample
    conv_p_list, conv_s_list, v_p_list, v_s_list = [], [], [], []
    for i in range(DEPTH):
        w_i = (g_mix[i], w_in[i], b_in[i], conv_w[i], conv_b[i], ln_a_g[i], ln_a_b[i], w_a_out[i],
               ln_v_g[i], ln_v_b[i], w_s[i], b_s[i], w_b_out[i], w_o[i], g_ffn[i], w_ff1[i],
               w_ff2[i], g_ple[i], w_ple[i], w_ple_gate[i], b_ple_gate[i])
        zero_hist = jnp.zeros((xp.shape[0], CONV_WIDTH - 1, C_A), dtype=xp.dtype)
        xp, conv_p, v_p = _layer(xp, zero_hist, p_prompt[i], *w_i)
        xs, conv_s, v_s = _layer(xs, state_conv[i], p_sample[i], *w_i)
        conv_p_list.append(conv_p)
        conv_s_list.append(conv_s)
        v_p_list.append(v_p)
        v_s_list.append(v_s)
    y_prompt = _rmsnorm(xp, g_final)
    y_sample = _rmsnorm(xs, g_final)
    conv_prompt = jnp.stack(conv_p_list, axis=0)
    conv_sample = jnp.stack(conv_s_list, axis=0)
    v_prompt = jnp.stack(v_p_list, axis=0)
    v_sample = jnp.stack(v_s_list, axis=0)
    return (y_prompt, y_sample, conv_prompt, conv_sample, v_prompt, v_sample)
```

```cpp
#include <hip/hip_runtime.h>
#include <hip/hip_cooperative_groups.h>
#include <cstdio>
#include <cstdint>
namespace cg = cooperative_groups;
namespace pg8 {
#define PG8_LAS __attribute__((address_space(3)))
typedef unsigned short bf16_t;
typedef short bf16x8 __attribute__((ext_vector_type(8)));
typedef float f32x4 __attribute__((ext_vector_type(4)));
typedef unsigned u32x4 __attribute__((ext_vector_type(4)));
__device__ __forceinline__ int lane_now() { int l; asm volatile("v_mbcnt_lo_u32_b32 %0, -1, 0\n\tv_mbcnt_hi_u32_b32 %0, -1, %0" : "=v"(l)); return l & 63; }
constexpr int BM = 256, BK = 64, HALF = 128, HTB = HALF * BK * 2  , STAGE_BYTES = 8 * HTB, NXCD = 8, WGM = 8;

__host__ __device__ __forceinline__ int lds_byte(int r, int c) { const int st = (r >> 4) * 2 + (c >> 5), rr = r & 15, cc = c & 31, ob = rr * 64 + cc * 2; return st * 1024 + (ob ^ (((ob >> 9) & 1) << 5)); }
__host__ __device__ __forceinline__ void stage_rc(int b, int& R, int& C) { const int st = b / 1024, sb = b % 1024, swz = sb ^ (((sb >> 9) & 1) << 5); R = (st >> 1) * 16 + swz / 64; C = (st & 1) * 32 + (swz % 64) / 2; }
__host__ __device__ __forceinline__ int perm32(int rho) { const int n = rho >> 4, i = rho & 15; return 8 * (i >> 2) + 4 * n + (i & 3); }

struct Unit { int pm, pn; };
struct Gemm { const bf16_t* A; const bf16_t* Bt; int M, N, K; };

struct StaticOrder {
    int nM, nN, nwg, G, c;
    __host__ __device__ void init(int M, int N, int G_, int c_) { nM = M / BM; nN = N / BM; nwg = nM * nN; G = G_; c = c_; }
    __host__ __device__ bool next(int i, Unit& u) const {
        const long L = (long)i * G + c; if (L >= nwg) return false;
        int wgid = (int)L; { const int q = nwg / NXCD, r = nwg % NXCD, xcd = wgid % NXCD, off = wgid / NXCD; wgid = (xcd < r ? xcd * (q + 1) : r * (q + 1) + (xcd - r) * q) + off; }
        const int nig = WGM * nN, gid = wgid / nig, fm = gid * WGM, gsz = (nM - fm) < WGM ? (nM - fm) : WGM;
        u.pm = fm + ((wgid % nig) % gsz); u.pn = (wgid % nig) / gsz; return true;
    }
    __device__ __forceinline__ void a_ready(const Unit&) const {}
    __device__ __forceinline__ void done(const Unit&) const {}
};

__device__ __forceinline__ unsigned cvt_pk_bf16(float lo, float hi) { unsigned r; asm volatile("v_cvt_pk_bf16_f32 %0, %1, %2" : "=v"(r) : "v"(lo), "v"(hi)); return r; }
typedef float f32x2 __attribute__((ext_vector_type(2)));
__device__ __forceinline__ f32x2 gelu_pk(f32x2 v) {
    const f32x2 av = __builtin_elementwise_abs(v), d = av * 0.2316418882f + 1.0f;
    f32x2 t; t.x = __builtin_amdgcn_rcpf(d.x); t.y = __builtin_amdgcn_rcpf(d.y);
    f32x2 q = t * 0.5307027145f + (-0.7265760135f); q = q * t + 0.7107068705f; q = q * t + (-0.142248368f); q = q * t + 0.127414796f; q = q * t;
    const f32x2 s = (v * v) * (-0.72134752044f);
    f32x2 e; e.x = __builtin_amdgcn_exp2f(s.x); e.y = __builtin_amdgcn_exp2f(s.y);
    const f32x2 m = v * (q * e), r = v - m;
    f32x2 o; o.x = v.x < 0.f ? m.x : r.x; o.y = v.y < 0.f ? m.y : r.y; return o;
}
typedef unsigned u32x2 __attribute__((ext_vector_type(2)));
constexpr int MP = 16384, MS = 512, MT = MP + MS;
constexpr long O_Y = 0, O_CONVP = 17301504, O_CONVS = 17793024, O_VP = 25657344, O_VS = 28803072;
__device__ __forceinline__ float bf_lo(unsigned w) { return __uint_as_float(w << 16); }
__device__ __forceinline__ float bf_hi(unsigned w) { return __uint_as_float(w & 0xffff0000u); }
__device__ __forceinline__ float sigm(float x) { return __builtin_amdgcn_rcpf(1.f + __builtin_amdgcn_exp2f(-1.44269504f * x)); }
__device__ __forceinline__ float gelu_t(float x) { const float y = 0.7978845608f * (x + 0.044715f * x * x * x); return x * __builtin_amdgcn_rcpf(1.f + __builtin_amdgcn_exp2f(-2.88539008f * y)); }
__device__ __forceinline__ u32x4 pack8(const f32x4 a, const f32x4 b) { u32x4 w; w.x = cvt_pk_bf16(a[0], a[1]); w.y = cvt_pk_bf16(a[2], a[3]); w.z = cvt_pk_bf16(b[0], b[1]); w.w = cvt_pk_bf16(b[2], b[3]); return w; }
__device__ __forceinline__ void unpack8(const u32x4 w, f32x4& a, f32x4& b) { a = (f32x4){bf_lo(w.x), bf_hi(w.x), bf_lo(w.y), bf_hi(w.y)}; b = (f32x4){bf_lo(w.z), bf_hi(w.z), bf_lo(w.w), bf_hi(w.w)}; }
__device__ __forceinline__ float sum4(const f32x4 a) { return (a[0] + a[1]) + (a[2] + a[3]); }
__device__ __forceinline__ float ssq4(const f32x4 a) { return (a[0] * a[0] + a[1] * a[1]) + (a[2] * a[2] + a[3] * a[3]); }
__device__ __forceinline__ void row_rs(const float* ssq, int rowt  , int fr, int fq, float (&rs)[2][4]) {
    float t[2];
#pragma unroll
    for (int j = 0; j < 2; ++j) { const int r = rowt + 128 * (fq >> 1) + 16 * (2 * (fq & 1) + j) + fr; const f32x4* p = (const f32x4*)(ssq + (size_t)r * 16);
        const f32x4 a = (p[0] + p[1]) + (p[2] + p[3]); t[j] = 1.0f / sqrtf(sum4(a) * (1.0f / 1024.0f) + 1e-6f); }
#pragma unroll
    for (int ai = 0; ai < 2; ++ai)
#pragma unroll
        for (int m = 0; m < 4; ++m) rs[ai][m] = __shfl(t[m & 1], fr + 16 * (ai * 2 + (m >> 1)));
}
__device__ __forceinline__ void st16_async(void* p, u32x4 v) { asm volatile("global_store_dwordx4 %0, %1, off\n\ts_nop 1" :: "v"(p), "v"(v) : "memory"); }
__device__ __forceinline__ void st4_async(void* p, float v) { asm volatile("global_store_dword %0, %1, off\n\ts_nop 0" :: "v"(p), "v"(v) : "memory"); }
#define EPI_ROW(ai, m) (u.pm * BM + (ai) * HALF + wr * 64 + (m) * 16 + fr)

struct EpiIn {
    static constexpr bool PERM = true, AFTER_DRAIN = false;
    const float* bias; const float* ssq; bf16_t* GLU; bf16_t* U; bf16_t* V; bf16_t* GA; bf16_t* GB; float* vstat; float* out; int layer;
    template <int AIL = 0, int AIH = 2> __device__ __forceinline__ void operator()(const f32x4 (&acc)[2][2][4][2], const Unit& u, int wr, int wc, int fr, int fq) const {
        float rs[2][4]; row_rs(ssq, u.pm * BM + wr * 64, fr, fq, rs);
        const int cb = u.pn * BM + wc * 32 + 8 * fq;
        const f32x4 b00 = *(const f32x4*)(bias + cb), b01 = *(const f32x4*)(bias + cb + 4), b10 = *(const f32x4*)(bias + cb + HALF), b11 = *(const f32x4*)(bias + cb + HALF + 4);
        if (u.pn < 8) {
            const int ch = u.pn * 128 + wc * 32 + 8 * fq;
#pragma unroll
            for (int ai = AIL; ai < AIH; ++ai)
#pragma unroll
                for (int m = 0; m < 4; ++m) { __builtin_amdgcn_sched_barrier(0); const int row = EPI_ROW(ai, m); const float r = rs[ai][m];
                    const f32x4 a0 = acc[ai][0][m][0] * r + b00, a1 = acc[ai][0][m][1] * r + b01, g0 = acc[ai][1][m][0] * r + b10, g1 = acc[ai][1][m][1] * r + b11;
                    f32x4 o0, o1;
#pragma unroll
                    for (int i = 0; i < 4; ++i) { o0[i] = a0[i] * sigm(g0[i]); o1[i] = a1[i] * sigm(g1[i]); }
                    *(u32x4*)(GLU + (size_t)row * 1024 + ch) = pack8(o0, o1);
                    if (row < MP) { const int tt = row & 2047; if (tt >= 2018) { float* o = out + O_CONVP + ((size_t)(layer * 8 + (row >> 11)) * 30 + (tt - 2018)) * 1024 + ch; *(f32x4*)o = o0; *(f32x4*)(o + 4) = o1; } }
                    else { const int sr = row - MP; float* o = out + O_CONVS + ((size_t)(layer * 128 + (sr >> 2)) * 30 + 26 + (sr & 3)) * 1024 + ch; *(f32x4*)o = o0; *(f32x4*)(o + 4) = o1; } }
        } else if (u.pn < 20) {
            const bool isv = u.pn >= 14; bf16_t* base = isv ? V : U; const int ct = (u.pn - (isv ? 14 : 8)) * BM + wc * 32 + 8 * fq;
#pragma unroll
            for (int ai = AIL; ai < AIH; ++ai)
#pragma unroll
                for (int m = 0; m < 4; ++m) { __builtin_amdgcn_sched_barrier(0); const int row = EPI_ROW(ai, m); const float r = rs[ai][m]; float s1 = 0.f, s2 = 0.f;
#pragma unroll
                    for (int bj = 0; bj < 2; ++bj) { f32x4 z0 = acc[ai][bj][m][0] * r + (bj ? b10 : b00), z1 = acc[ai][bj][m][1] * r + (bj ? b11 : b01);
#pragma unroll
                        for (int i = 0; i < 4; ++i) { z0[i] = gelu_t(z0[i]); z1[i] = gelu_t(z1[i]); }
                        s1 += sum4(z0) + sum4(z1); s2 += ssq4(z0) + ssq4(z1);
                        *(u32x4*)(base + (size_t)row * 1536 + ct + bj * HALF) = pack8(z0, z1); }
                    if (isv) { s1 += __shfl_xor(s1, 16); s1 += __shfl_xor(s1, 32); s2 += __shfl_xor(s2, 16); s2 += __shfl_xor(s2, 32);
                        if (fq == 0) *(f32x2*)(vstat + ((size_t)row * 24 + (u.pn - 14) * 4 + wc) * 2) = (f32x2){s1, s2}; } }
        } else {
            const int ch = (u.pn - 20) * 128 + wc * 32 + 8 * fq;
#pragma unroll
            for (int ai = AIL; ai < AIH; ++ai)
#pragma unroll
                for (int m = 0; m < 4; ++m) { __builtin_amdgcn_sched_barrier(0); const int row = EPI_ROW(ai, m); const float r = rs[ai][m];
                    f32x4 a0 = acc[ai][0][m][0] * r + b00, a1 = acc[ai][0][m][1] * r + b01, g0 = acc[ai][1][m][0] * r + b10, g1 = acc[ai][1][m][1] * r + b11;
#pragma unroll
                    for (int i = 0; i < 4; ++i) { a0[i] = sigm(a0[i]); a1[i] = sigm(a1[i]); g0[i] = sigm(g0[i]); g1[i] = sigm(g1[i]); }
                    *(u32x4*)(GA + (size_t)row * 1024 + ch) = pack8(a0, a1); *(u32x4*)(GB + (size_t)row * 1024 + ch) = pack8(g0, g1); }
        }
    }
};
template <int MODE> struct EpiMul {
    static constexpr bool PERM = true, AFTER_DRAIN = false;
    bf16_t* G; const bf16_t* G2; const float* ssq; int ldc;
    template <int AIL = 0, int AIH = 2, int ML = 0, int MH = 4> __device__ __forceinline__ void operator()(const f32x4 (&acc)[2][2][4][2], const Unit& u, int wr, int wc, int fr, int fq) const {
        float rs[2][4];
        if (MODE == 3) row_rs(ssq, u.pm * BM + wr * 64, fr, fq, rs);
        const size_t cb = (size_t)u.pn * BM + wc * 32 + 8 * fq;
        constexpr int NB = ((MODE == 1) ? 2 : 4) < (MH - ML) ? ((MODE == 1) ? 2 : 4) : (MH - ML);
#pragma unroll
        for (int it0 = 4 * AIL + ML; it0 < 4 * (AIH - 1) + MH; it0 += NB) {
            u32x4 ga[NB][2], gb[NB][2];
            if (MODE == 0 || MODE == 1) {
#pragma unroll
                for (int k = 0; k < NB; ++k)
#pragma unroll
                    for (int bj = 0; bj < 2; ++bj) { const size_t off = (size_t)EPI_ROW((it0 + k) >> 2, (it0 + k) & 3) * ldc + cb + bj * HALF; ga[k][bj] = *(const u32x4*)(G + off); if (MODE == 1) gb[k][bj] = *(const u32x4*)(G2 + off); }
                __builtin_amdgcn_sched_barrier(0); }
#pragma unroll
            for (int k = 0; k < NB; ++k) { const int ai = (it0 + k) >> 2, m = (it0 + k) & 3; const int row = EPI_ROW(ai, m);
#pragma unroll
                for (int bj = 0; bj < 2; ++bj) { const size_t off = (size_t)row * ldc + cb + bj * HALF;
                    f32x4 v0 = acc[ai][bj][m][0], v1 = acc[ai][bj][m][1];
                    if (MODE == 0 || MODE == 1) { f32x4 g0, g1; unpack8(ga[k][bj], g0, g1); v0 = v0 * g0; v1 = v1 * g1; }
                    if (MODE == 1) { f32x4 g0, g1; unpack8(gb[k][bj], g0, g1); v0 = v0 + g0; v1 = v1 + g1; }
                    if (MODE == 3) { const float r2 = rs[ai][m] * rs[ai][m];
#pragma unroll
                        for (int i = 0; i < 4; ++i) { const float a = fmaxf(v0[i], 0.f), b = fmaxf(v1[i], 0.f); v0[i] = a * a * r2; v1[i] = b * b * r2; } }
                    *(u32x4*)(G + off) = pack8(v0, v1); }
                __builtin_amdgcn_sched_barrier(0); }
        }
    }
};
template <bool PLE> struct EpiRes {
    static constexpr bool PERM = true, AFTER_DRAIN = false;
    const bf16_t* XS; bf16_t* XO; float* ssq_out; const float* ssq_in; const float* bias; const bf16_t* PE;
    template <int AIL = 0, int AIH = 2, int ML = 0, int MH = 4> __device__ __forceinline__ void operator()(const f32x4 (&acc)[2][2][4][2], const Unit& u, int wr, int wc, int fr, int fq) const {
        float rs[2][4];
        if (PLE) row_rs(ssq_in, u.pm * BM + wr * 64, fr, fq, rs);
        const int cb = u.pn * BM + wc * 32 + 8 * fq;
        f32x4 bb[2][2];
        if (PLE) {
#pragma unroll
            for (int bj = 0; bj < 2; ++bj) { bb[bj][0] = *(const f32x4*)(bias + cb + bj * HALF); bb[bj][1] = *(const f32x4*)(bias + cb + bj * HALF + 4); } }
        constexpr int NB = (PLE ? 2 : 4) < (MH - ML) ? (PLE ? 2 : 4) : (MH - ML);
#pragma unroll
        for (int it0 = 4 * AIL + ML; it0 < 4 * (AIH - 1) + MH; it0 += NB) {
            u32x4 xa[NB][2], pa[NB][2];
#pragma unroll
            for (int k = 0; k < NB; ++k)
#pragma unroll
                for (int bj = 0; bj < 2; ++bj) { const size_t off = (size_t)EPI_ROW((it0 + k) >> 2, (it0 + k) & 3) * 1024 + cb + bj * HALF; xa[k][bj] = *(const u32x4*)(XS + off); if (PLE) pa[k][bj] = *(const u32x4*)(PE + off); }
            __builtin_amdgcn_sched_barrier(0);
#pragma unroll
            for (int k = 0; k < NB; ++k) { const int ai = (it0 + k) >> 2, m = (it0 + k) & 3; const int row = EPI_ROW(ai, m); float ss = 0.f;
#pragma unroll
                for (int bj = 0; bj < 2; ++bj) { const size_t off = (size_t)row * 1024 + cb + bj * HALF;
                    f32x4 v0 = acc[ai][bj][m][0], v1 = acc[ai][bj][m][1];
                    if (PLE) { f32x4 p0, p1; unpack8(pa[k][bj], p0, p1); const float r = rs[ai][m];
#pragma unroll
                        for (int i = 0; i < 4; ++i) { v0[i] = sigm(v0[i] * r + bb[bj][0][i]) * p0[i]; v1[i] = sigm(v1[i] * r + bb[bj][1][i]) * p1[i]; } }
                    f32x4 x0, x1; unpack8(xa[k][bj], x0, x1); x0 = x0 + v0; x1 = x1 + v1;
                    *(u32x4*)(XO + off) = pack8(x0, x1);
                    ss += ssq4(x0) + ssq4(x1); }
                ss += __shfl_xor(ss, 16); ss += __shfl_xor(ss, 32);
                if (fq == 0) ssq_out[(size_t)row * 16 + u.pn * 4 + wc] = ss;
                __builtin_amdgcn_sched_barrier(0); }
        }
    }
};

struct EpiNop {
    static constexpr bool PERM = true, AFTER_DRAIN = false;
    template <int AIL = 0, int AIH = 2> __device__ __forceinline__ void operator()(const f32x4 (&acc)[2][2][4][2], const Unit&, int, int, int, int) const {
#pragma unroll
        for (int a = AIL; a < AIH; ++a)
#pragma unroll
            for (int b = 0; b < 2; ++b)
#pragma unroll
                for (int mm = 0; mm < 4; ++mm)
#pragma unroll
                    for (int n = 0; n < 2; ++n) asm volatile("" :: "v"(acc[a][b][mm][n]));
    }
};

template <class E0> struct EpiTwice {
    static constexpr bool PERM = true, AFTER_DRAIN = false;
    E0 e;
    template <int AIL = 0, int AIH = 2> __device__ __forceinline__ void operator()(const f32x4 (&acc)[2][2][4][2], const Unit& u, int wr, int wc, int fr, int fq) const { e.template operator()<AIL, AIH>(acc, u, wr, wc, fr, fq); asm volatile("" ::: "memory"); e.template operator()<AIL, AIH>(acc, u, wr, wc, fr, fq); }
};
template <class Epi, class Sched, bool ALIGN_EPI = false, bool SP2 = false>
__device__ __forceinline__ void gemm_phase(PG8_LAS unsigned char* lds, const Gemm g, const Sched& S, const Epi& E, int wv  ) {
    int tid_ = wv * 64 + lane_now();
    const int tid = tid_, wid = __builtin_amdgcn_readfirstlane(tid >> 6), lane = tid & 63, wr = wid >> 2, wc = wid & 3, fr = lane & 15, fq = lane >> 4;
    const int K = g.K, nt = K / BK;
    unsigned voffA[2], voffB[2];
#pragma unroll
    for (int i = 0; i < 2; ++i) { int R, C; stage_rc(tid * 16 + i * 8192, R, C); const int Rb = Epi::PERM ? ((R & ~31) + perm32(R & 31)) : R;
        voffA[i] = (unsigned)(R * K + C) * 2u; voffB[i] = (unsigned)(Rb * K + C) * 2u; }
    const size_t kstep = (size_t)(BK * 2);
    const size_t hstep = (size_t)HALF * K * 2;
    const size_t tstep = 2 * hstep;
    const unsigned ldsw = (unsigned)wid * 1024u;
    const int aoff = lds_byte(wr * 64 + fr, fq * 8), boff = lds_byte(wc * 32 + fr, fq * 8);
#define PG8_SA(b, h) (((b) * 2 + (h)) * HTB)
#define PG8_SB(b, h) ((4 + (b) * 2 + (h)) * HTB)
#define PG8_STAGE(bufoff, gbase, voff) do { _Pragma("unroll") for (int _i = 0; _i < 2; ++_i) \
        __builtin_amdgcn_global_load_lds((const unsigned*)((const char*)(gbase) + (voff)[_i]), (PG8_LAS unsigned*)(lds + (bufoff) + ldsw + _i * 8192), 16, 0, 0); } while (0)
#define PG8_LDA(dst, b, h) do { _Pragma("unroll") for (int m = 0; m < 4; ++m) _Pragma("unroll") for (int k = 0; k < 2; ++k) dst[m][k] = *(const PG8_LAS bf16x8*)(lds + PG8_SA(b, h) + aoff + m * 2048 + k * 1024); } while (0)
#define PG8_LDB(dst, b, h) do { _Pragma("unroll") for (int n = 0; n < 2; ++n) _Pragma("unroll") for (int k = 0; k < 2; ++k) dst[n][k] = *(const PG8_LAS bf16x8*)(lds + PG8_SB(b, h) + boff + n * 2048 + k * 1024); } while (0)
#define PG8_MMA(ai, bj, At, Bt) do { __builtin_amdgcn_s_setprio(1); _Pragma("unroll") for (int m = 0; m < 4; ++m) _Pragma("unroll") for (int n = 0; n < 2; ++n) _Pragma("unroll") for (int k = 0; k < 2; ++k) \
        acc[ai][bj][m][n] = __builtin_amdgcn_mfma_f32_16x16x32_bf16(Bt[n][k], At[m][k], acc[ai][bj][m][n], 0, 0, 0); __builtin_amdgcn_s_setprio(0); } while (0)
#define PG8_WAIT_V(n) asm volatile("s_waitcnt vmcnt(" #n ")" ::: "memory")
#define PG8_WAIT_L(n) asm volatile("s_waitcnt lgkmcnt(" #n ")" ::: "memory")
#define PG8_BAR __builtin_amdgcn_s_barrier()
#define PG8_SCHED __builtin_amdgcn_sched_barrier(0)
    Unit cur, nxt; int ui = 0;
    if (!S.next(0, cur)) return;
    f32x4 acc[2][2][4][2];
#pragma unroll
    for (int a = 0; a < 2; ++a)
#pragma unroll
        for (int b = 0; b < 2; ++b)
#pragma unroll
            for (int m = 0; m < 4; ++m)
#pragma unroll
                for (int n = 0; n < 2; ++n) acc[a][b][m][n] = (f32x4){0.f, 0.f, 0.f, 0.f};
    bf16x8 At[4][2], B0[2][2], B1[2][2];
    const char* cA = (const char*)g.A + (size_t)cur.pm * tstep; const char* cB = (const char*)g.Bt + (size_t)cur.pn * tstep;
    S.a_ready(cur);
    if constexpr (SP2) {
        PG8_STAGE(PG8_SB(0, 0), cB, voffB); PG8_STAGE(PG8_SB(0, 1), cB + hstep, voffB); PG8_STAGE(PG8_SA(0, 0), cA, voffA); PG8_STAGE(PG8_SA(0, 1), cA + hstep, voffA);
        if (wr == 1) PG8_BAR;
        PG8_WAIT_V(2); PG8_BAR;
        PG8_STAGE(PG8_SB(1, 0), cB + kstep, voffB); PG8_STAGE(PG8_SA(1, 0), cA + kstep, voffA); PG8_STAGE(PG8_SB(1, 1), cB + hstep + kstep, voffB);
        PG8_WAIT_V(6); PG8_BAR;
    } else {
        PG8_STAGE(PG8_SB(0, 0), cB, voffB); PG8_STAGE(PG8_SA(0, 0), cA, voffA); PG8_STAGE(PG8_SB(0, 1), cB + hstep, voffB); PG8_STAGE(PG8_SA(0, 1), cA + hstep, voffA);
        if (wr == 1) PG8_BAR;
        PG8_WAIT_V(4); PG8_BAR;
        PG8_STAGE(PG8_SB(1, 0), cB + kstep, voffB); PG8_STAGE(PG8_SA(1, 0), cA + kstep, voffA); PG8_STAGE(PG8_SB(1, 1), cB + hstep + kstep, voffB);
        PG8_WAIT_V(6); PG8_BAR;
    }
    for (;;) {
        const bool has_next = S.next(ui + 1, nxt);
        const char* nA = has_next ? (const char*)g.A + (size_t)nxt.pm * tstep : cA; const char* nB = has_next ? (const char*)g.Bt + (size_t)nxt.pn * tstep : cB;
        for (int t = 0; t < nt; t += 2) {
            const bool last = (t == nt - 2);
            const char* a1 = cA + (size_t)(t + 1) * kstep;
            const char* a2 = last ? nA : cA + (size_t)(t + 2) * kstep; const char* b2 = last ? nB : cB + (size_t)(t + 2) * kstep;
            const char* a3 = a2 + kstep; const char* b3 = b2 + kstep;
            if (last && has_next) S.a_ready(nxt);
            if constexpr (SP2) {
            PG8_LDB(B0, 0, 0); PG8_LDB(B1, 0, 1); PG8_SCHED; PG8_LDA(At, 0, 0); PG8_STAGE(PG8_SA(1, 1), a1 + hstep, voffA);
            PG8_WAIT_V(8); PG8_WAIT_L(0); PG8_BAR; PG8_MMA(0, 0, At, B0); PG8_MMA(0, 1, At, B1); PG8_BAR; PG8_SCHED;
            PG8_LDA(At, 0, 1); PG8_STAGE(PG8_SB(0, 0), b2, voffB); PG8_STAGE(PG8_SB(0, 1), b2 + hstep, voffB); PG8_STAGE(PG8_SA(0, 0), a2, voffA);
            PG8_WAIT_V(8); PG8_WAIT_L(0); PG8_BAR; PG8_MMA(1, 0, At, B0); PG8_MMA(1, 1, At, B1); PG8_BAR; PG8_SCHED;
            PG8_LDB(B0, 1, 0); PG8_LDB(B1, 1, 1); PG8_SCHED; PG8_LDA(At, 1, 0); PG8_STAGE(PG8_SA(0, 1), a2 + hstep, voffA);
            PG8_WAIT_V(8); PG8_WAIT_L(0); PG8_BAR; PG8_MMA(0, 0, At, B0); PG8_MMA(0, 1, At, B1); PG8_BAR; PG8_SCHED;
            PG8_LDA(At, 1, 1); PG8_STAGE(PG8_SB(1, 0), b3, voffB); PG8_STAGE(PG8_SB(1, 1), b3 + hstep, voffB); PG8_STAGE(PG8_SA(1, 0), a3, voffA);
            PG8_WAIT_V(8); PG8_WAIT_L(0); PG8_BAR; PG8_MMA(1, 0, At, B0); PG8_MMA(1, 1, At, B1); PG8_BAR; PG8_SCHED;
            } else {
            PG8_LDB(B0, 0, 0); PG8_SCHED; PG8_LDA(At, 0, 0); PG8_STAGE(PG8_SA(1, 1), a1 + hstep, voffA);
            PG8_WAIT_L(8); PG8_BAR; PG8_WAIT_L(0); PG8_MMA(0, 0, At, B0); PG8_BAR; PG8_SCHED;
            PG8_LDB(B1, 0, 1); PG8_STAGE(PG8_SB(0, 0), b2, voffB);
            PG8_BAR; PG8_WAIT_L(0); PG8_MMA(0, 1, At, B1); PG8_BAR;
            PG8_LDA(At, 0, 1); PG8_STAGE(PG8_SA(0, 0), a2, voffA);
            PG8_BAR; PG8_WAIT_L(0); PG8_MMA(1, 0, At, B0); PG8_BAR; PG8_SCHED;
            PG8_STAGE(PG8_SB(0, 1), b2 + hstep, voffB);
            PG8_WAIT_V(6); PG8_BAR; PG8_MMA(1, 1, At, B1); PG8_BAR;
            PG8_LDB(B0, 1, 0); PG8_SCHED; PG8_LDA(At, 1, 0); PG8_STAGE(PG8_SA(0, 1), a2 + hstep, voffA);
            PG8_WAIT_L(8); PG8_BAR; PG8_WAIT_L(0); PG8_MMA(0, 0, At, B0); PG8_BAR; PG8_SCHED;
            PG8_LDB(B1, 1, 1); PG8_STAGE(PG8_SB(1, 0), b3, voffB);
            PG8_BAR; PG8_WAIT_L(0); PG8_MMA(0, 1, At, B1); PG8_BAR;
            PG8_LDA(At, 1, 1); PG8_STAGE(PG8_SA(1, 0), a3, voffA);
            PG8_BAR; PG8_WAIT_L(0); PG8_MMA(1, 0, At, B0); PG8_BAR; PG8_SCHED;
            PG8_STAGE(PG8_SB(1, 1), b3 + hstep, voffB);
            PG8_WAIT_V(6); PG8_BAR; PG8_MMA(1, 1, At, B1); PG8_BAR;
            }
        }
        if constexpr (ALIGN_EPI) { if (wr == 0) PG8_BAR; }
        if constexpr (!Epi::AFTER_DRAIN) { E(acc, cur, wr, wc, fr, fq); S.done(cur); }
        if (!has_next) break;
#pragma unroll
        for (int a = 0; a < 2; ++a)
#pragma unroll
            for (int b = 0; b < 2; ++b)
#pragma unroll
                for (int m = 0; m < 4; ++m)
#pragma unroll
                    for (int n = 0; n < 2; ++n) acc[a][b][m][n] = (f32x4){0.f, 0.f, 0.f, 0.f};
        cur = nxt; cA = nA; cB = nB; ++ui;
        if constexpr (ALIGN_EPI) { if (wr == 1) PG8_BAR; }
    }
    PG8_WAIT_V(0);
    if constexpr (!ALIGN_EPI) { if (wr == 0) PG8_BAR; }
    PG8_BAR;
    if constexpr (Epi::AFTER_DRAIN) { E.fused(acc, cur, wr, wc, fr, fq, lds, wid, lane); S.done(cur); }
#undef PG8_SA
#undef PG8_SB
#undef PG8_STAGE
#undef PG8_LDA
#undef PG8_LDB
#undef PG8_MMA
#undef PG8_WAIT_V
#undef PG8_WAIT_L
#undef PG8_BAR
#undef PG8_SCHED
}
}

#ifndef MK_PROBE
#define MK_PROBE 0
#endif
#define LAS __attribute__((address_space(3)))
using pg8::bf16_t; using pg8::f32x4; using pg8::f32x2; using pg8::u32x4; using pg8::bf16x8; using pg8::MP; using pg8::MS; using pg8::MT;
using pg8::O_CONVP; using pg8::O_CONVS; using pg8::O_VP; using pg8::O_VS;
constexpr int NWAVES = 8, NTHR = 512;
constexpr int LDS_BYTES = 147456;
constexpr int DM = 1024, CA = 1024, CB = 1536, DIN = 7168, DFF = 4096, PDIM = 256;
constexpr float EPS = 1e-6f;
constexpr size_t al256(size_t x) { return (x + 255) & ~(size_t)255; }
constexpr size_t WS_CTL = 0;
constexpr size_t WS_WIN = 65536;
constexpr size_t WS_WA = WS_WIN + (size_t)DIN * DM * 2;
constexpr size_t WS_WB = WS_WA + (size_t)DM * CA * 2;
constexpr size_t WS_WO = WS_WB + (size_t)DM * CB * 2;
constexpr size_t WS_W1 = WS_WO + (size_t)DM * DM * 2;
constexpr size_t WS_W2 = WS_W1 + (size_t)DFF * DM * 2;
constexpr size_t WS_WPG = WS_W2 + (size_t)DM * DFF * 2;
constexpr size_t WS_WPE = WS_WPG + (size_t)DM * DM * 2;
constexpr size_t WS_BIN = WS_WPE + (size_t)DM * PDIM * 2;
constexpr size_t WS_XB = WS_BIN + (size_t)DIN * 4;
constexpr size_t WS_PB = WS_XB + (size_t)MT * DM * 2;
constexpr size_t WS_U = WS_PB + (size_t)MT * PDIM * 2;
constexpr size_t WS_GLU = WS_U + (size_t)MT * CB * 2;
constexpr size_t WS_V = WS_GLU + (size_t)MT * CA * 2;
constexpr size_t WS_H = WS_U;
constexpr size_t WS_GA = WS_V + (size_t)MT * CB * 2;
constexpr size_t WS_GB = WS_GA + (size_t)MT * DM * 2;
constexpr size_t WS_SSA = WS_GB + (size_t)MT * DM * 2;
constexpr size_t WS_SSB = WS_SSA + (size_t)MT * 16 * 4;
constexpr size_t WS_VST = WS_SSB + (size_t)MT * 16 * 4;
constexpr size_t WS_END = WS_VST + (size_t)MT * 48 * 4;
static_assert(WS_H + (size_t)MT * DFF * 2 == WS_GA, "h overlays u|glu|v exactly");
static_assert(WS_END <= 302395392, "d_ws map must fit sum(inputs) bytes");

struct Params { const float* in[27]; float* out; unsigned char* ws; int ph_lo, ph_hi; };

__device__ __forceinline__ float wave_sum(float v) {
#pragma unroll
    for (int o = 1; o < 64; o <<= 1) v += __shfl_xor(v, o);
    return v;
}
__device__ __forceinline__ unsigned pk2(float lo, float hi) { return pg8::cvt_pk_bf16(lo, hi); }

__device__ __forceinline__ void tr_load(f32x4 (&v)[8], const float* W, int Nsrc, int srccol0, int k0, int lane) {
#pragma unroll
    for (int i = 0; i < 8; ++i) { const int kk = 8 * i + (lane >> 3); v[i] = __builtin_nontemporal_load((const f32x4*)(W + (size_t)(k0 + kk) * Nsrc + srccol0 + 4 * (lane & 7))); }
}
__device__ __forceinline__ void tr_finish(const f32x4 (&v)[8], int K, const float* gain, bf16_t* WT, int n0, int k0, LAS float* scr, int lane) {
#pragma unroll
    for (int i = 0; i < 8; ++i) { const int kk = 8 * i + (lane >> 3); f32x4 x = v[i]; if (gain) x = x * gain[k0 + kk];
        LAS float* d = scr + kk * 33 + 4 * (lane & 7); d[0] = x[0]; d[1] = x[1]; d[2] = x[2]; d[3] = x[3]; }
    asm volatile("s_waitcnt lgkmcnt(0)" ::: "memory");
    const int c = lane & 7;
#pragma unroll
    for (int j = 0; j < 4; ++j) { const int n = (lane >> 3) + 8 * j; const LAS float* s = scr + (8 * c) * 33 + n;
        u32x4 o; o.x = pk2(s[0 * 33], s[1 * 33]); o.y = pk2(s[2 * 33], s[3 * 33]); o.z = pk2(s[4 * 33], s[5 * 33]); o.w = pk2(s[6 * 33], s[7 * 33]);
        pg8::st16_async(WT + (size_t)(n0 + n) * K + k0 + 8 * c, o); }
    asm volatile("s_waitcnt lgkmcnt(0)" ::: "memory");
}
__device__ __forceinline__ int win_src(int n) {
    if (n < 2048) return ((n >> 7) & 1) * 1024 + 128 * (n >> 8) + (n & 127);
    if (n < 5120) return n;
    const int n2 = n - 5120; return 5120 + ((n2 >> 7) & 1) * 1024 + 128 * (n2 >> 8) + (n2 & 127);
}
__device__ __forceinline__ void convert1(const Params& P, int layer, unsigned mask, LAS unsigned char* lds, int gw, int ngw, int lane) {
    lane = pg8::lane_now();
    const int wv_ = gw & 7;
    LAS float* scr = (LAS float*)(lds + 65536 + wv_ * 8448);
    unsigned char* ws = P.ws;
    const int  Ks[8] = {1024, 1024, 1536, 1024, 1024, 4096, 1024, 256};
    const int  Ns[8] = {7168, 1024, 1024, 1024, 4096, 1024, 1024, 1024};
#pragma unroll
    for (int id = 0; id < 8; ++id) {
        if (!(mask & (1u << id))) continue;
        const int K = Ks[id], N = Ns[id];
        const float* W; const float* gain = nullptr; bf16_t* WT;
        switch (id) {
            case 0: W = P.in[6] + (size_t)layer * DM * DIN; gain = P.in[5] + layer * DM; WT = (bf16_t*)(ws + WS_WIN); break;
            case 1: W = P.in[12] + (size_t)layer * CA * DM; WT = (bf16_t*)(ws + WS_WA); break;
            case 2: W = P.in[17] + (size_t)layer * CB * DM; WT = (bf16_t*)(ws + WS_WB); break;
            case 3: W = P.in[18] + (size_t)layer * DM * DM; WT = (bf16_t*)(ws + WS_WO); break;
            case 4: W = P.in[20] + (size_t)layer * DM * DFF; gain = P.in[19] + layer * DM; WT = (bf16_t*)(ws + WS_W1); break;
            case 5: W = P.in[21] + (size_t)layer * DFF * DM; WT = (bf16_t*)(ws + WS_W2); break;
            case 6: W = P.in[24] + (size_t)layer * DM * DM; gain = P.in[22] + layer * DM; WT = (bf16_t*)(ws + WS_WPG); break;
            default: W = P.in[23] + (size_t)layer * PDIM * DM; WT = (bf16_t*)(ws + WS_WPE); break;
        }
        const int nblk = N / 32, nitems = (K / 64) * nblk;
        {   f32x4 va[8], vb[8]; int it = gw;
            if (it < nitems) { const int n0 = 32 * (it % nblk); tr_load(va, W, N, id == 0 ? win_src(n0) : n0, 64 * (it / nblk), lane); }
            for (; it < nitems; it += 2 * ngw) {
                const int i1 = it + ngw, i2 = it + 2 * ngw;
                if (i1 < nitems) { const int n0 = 32 * (i1 % nblk); tr_load(vb, W, N, id == 0 ? win_src(n0) : n0, 64 * (i1 / nblk), lane); }
                __builtin_amdgcn_sched_barrier(0);
                tr_finish(va, K, gain, WT, 32 * (it % nblk), 64 * (it / nblk), scr, lane);
                __builtin_amdgcn_sched_barrier(0);
                if (i1 < nitems) {
                    if (i2 < nitems) { const int n0 = 32 * (i2 % nblk); tr_load(va, W, N, id == 0 ? win_src(n0) : n0, 64 * (i2 / nblk), lane); }
                    __builtin_amdgcn_sched_barrier(0);
                    tr_finish(vb, K, gain, WT, 32 * (i1 % nblk), 64 * (i1 / nblk), scr, lane);
                    __builtin_amdgcn_sched_barrier(0);
                }
            }
        }
    }
    if (mask & 256u) {
        float* binp = (float*)(ws + WS_BIN); const float* b_in = P.in[7] + layer * DIN;
        for (int i = gw * 64 + lane; i < DIN; i += ngw * 64) binp[i] = b_in[win_src(i)];
    }
    if (mask & 512u) {
        bf16_t* PB = (bf16_t*)(ws + WS_PB);
        for (int r = gw; r < MT; r += ngw) {
            const float* src = r < MP ? P.in[3] + ((size_t)layer * MP + r) * PDIM : P.in[4] + ((size_t)layer * MS + (r - MP)) * PDIM;
            const f32x4 v = __builtin_nontemporal_load((const f32x4*)src + lane);
            ((pg8::u32x2*)(PB + (size_t)r * PDIM))[lane] = (pg8::u32x2){pk2(v[0], v[1]), pk2(v[2], v[3])}; }
    }
}
__device__ __forceinline__ void convert(const Params& P, int layer, unsigned mask, LAS unsigned char* lds, int gw, int ngw, int lane) {
    convert1(P, layer, mask, lds, gw, ngw, lane);
#if (MK_PROBE & 8)
    convert1(P, layer, mask, lds, gw, ngw, lane);
#endif
}
__device__ __forceinline__ void x_to_bf16(const Params& P, int gw, int ngw, int lane) {
    bf16_t* XB = (bf16_t*)(P.ws + WS_XB); float* ssq = (float*)(P.ws + WS_SSA);
    const bool xl = (ngw == 2048);
    const int wl = (blockIdx.x >> 3) * 8 + (gw & 7), rb = (blockIdx.x & 7) * 2048 + 8 * wl;
    for (int q2 = 0; q2 < (xl ? 5 : 1 << 30); ++q2) {
        int r;
        if (xl) { if (q2 < 4) r = rb + 2 * q2; else { r = MP + 2 * gw; if (r >= MT) break; } } else { r = 2 * gw + q2 * 2 * ngw; if (r >= MT) break; }
        f32x4 v[2][4];
#pragma unroll
        for (int q = 0; q < 2; ++q) { const int rr = r + q; const float* src = rr < MP ? P.in[0] + (size_t)rr * DM : P.in[1] + (size_t)(rr - MP) * DM;
#pragma unroll
            for (int j = 0; j < 4; ++j) v[q][j] = __builtin_nontemporal_load((const f32x4*)src + lane + 64 * j); }
        __builtin_amdgcn_sched_barrier(0);
#pragma unroll
        for (int q = 0; q < 2; ++q) { const int rr = r + q; float s = 0.f;
#pragma unroll
            for (int j = 0; j < 4; ++j) { s += pg8::ssq4(v[q][j]); ((pg8::u32x2*)(XB + (size_t)rr * DM))[lane + 64 * j] = (pg8::u32x2){pk2(v[q][j][0], v[q][j][1]), pk2(v[q][j][2], v[q][j][3])}; }
            s = wave_sum(s);
            if (lane < 16) ssq[(size_t)rr * 16 + lane] = lane == 0 ? s : 0.f; }
    }
}
__device__ __forceinline__ void final_norm(const Params& P, int gw, int ngw, int lane) {
    const float* ssq = (const float*)(P.ws + WS_SSA); const float* g = P.in[26]; const bf16_t* XB = (const bf16_t*)(P.ws + WS_XB);
    f32x4 gg[4];
#pragma unroll
    for (int j = 0; j < 2; ++j) { const int c4 = 2 * (lane + 64 * j); gg[2 * j] = ((const f32x4*)g)[c4]; gg[2 * j + 1] = ((const f32x4*)g)[c4 + 1]; }
    const bool xl = (ngw == 2048);
    const int wl = (blockIdx.x >> 3) * 8 + (gw & 7), rb = (blockIdx.x & 7) * 2048 + 8 * wl;
    for (int q2 = 0; q2 < (xl ? 5 : 1 << 30); ++q2) {
        int r;
        if (xl) { if (q2 < 4) r = rb + 2 * q2; else { r = MP + 2 * gw; if (r >= MT) break; } } else { r = 2 * gw + q2 * 2 * ngw; if (r >= MT) break; }
        u32x4 xv[2][2]; float sv[2];
#pragma unroll
        for (int q = 0; q < 2; ++q) { const u32x4* xr = (const u32x4*)(XB + (size_t)(r + q) * DM); xv[q][0] = xr[lane]; xv[q][1] = xr[lane + 64]; sv[q] = lane < 16 ? ssq[(size_t)(r + q) * 16 + lane] : 0.f; }
        __builtin_amdgcn_sched_barrier(0);
#pragma unroll
        for (int q = 0; q < 2; ++q) { const float rs = 1.0f / sqrtf(wave_sum(sv[q]) * (1.0f / 1024.0f) + EPS); f32x4* row = (f32x4*)(P.out + (size_t)(r + q) * DM);
#pragma unroll
            for (int j = 0; j < 2; ++j) { f32x4 a, b; pg8::unpack8(xv[q][j], a, b); const int c4 = 2 * (lane + 64 * j); row[c4] = a * rs * gg[2 * j]; row[c4 + 1] = b * rs * gg[2 * j + 1]; } }
    }
}

#define TR_STAGE(B, N) { const bool up = (lane & (B)) != 0; _Pragma("unroll") for (int i = 0; i < (N); ++i) { const float keep = up ? sv[i + (N)] : sv[i]; const float send = up ? sv[i] : sv[i + (N)]; sv[i] = keep + __shfl_xor(send, (B)); } }
template <int NT, bool SAMPLE>
__device__ __forceinline__ void conv_items(const Params& P, int layer, LAS unsigned char* lds, int tid, int lane, int wave, int first, int nitems, int stride) {
    const bf16_t* GLU = (const bf16_t*)(P.ws + WS_GLU); bf16_t* AACT = (bf16_t*)P.out;
    LAS float* part = (LAS float*)lds; LAS float* tot = (LAS float*)(lds + 2048);
    const int c = 2 * tid;
    const float* cw = P.in[8] + (size_t)layer * 31 * CA + c;
    f32x2 w[31];
#pragma unroll
    for (int j = 0; j < 31; ++j) w[j] = *(const f32x2*)(cw + j * CA);
    const f32x2 cb = *(const f32x2*)(P.in[9] + layer * CA + c);
    const f32x2 lg = *(const f32x2*)(P.in[10] + layer * CA + c), lb = *(const f32x2*)(P.in[11] + layer * CA + c);
    unsigned xr[NT + 30];
#pragma unroll 1
    for (int item = first; item < nitems; item += stride) {
        f32x2 o[NT];
#pragma unroll
        for (int t = 0; t < NT; ++t) o[t] = cb;
        int rowbase, t0 = 64;
        if (!SAMPLE) { t0 = (item & 127) * 16; rowbase = (item >> 7) * 2048 + t0; } else rowbase = MP + 4 * item;
        f32x2 xs[SAMPLE ? 30 : 1];
        if (SAMPLE || stride != 1 || item == first || (item & 127) == 0) {
#pragma unroll
            for (int i = 0; i < NT + 30; ++i) {
                if (SAMPLE && i < 30) xs[SAMPLE ? i : 0] = *(const f32x2*)(P.in[2] + ((size_t)(layer * 128 + item) * 30 + i) * CA + c);
                else { const int di = (SAMPLE || i - 30 >= -t0) ? i - 30 : -t0;
                    xr[i] = *(const unsigned*)(GLU + (size_t)(rowbase + di) * CA + c); }
            }
        } else {
#pragma unroll
            for (int i = 0; i < 30; ++i) xr[i] = xr[i + NT];
#pragma unroll
            for (int k = 0; k < NT; ++k) xr[30 + k] = *(const unsigned*)(GLU + (size_t)(rowbase + k) * CA + c);
        }
        __builtin_amdgcn_sched_barrier(0);
#pragma unroll
        for (int i = 0; i < NT + 30; ++i) {
            f32x2 x;
            if (SAMPLE && i < 30) { x = xs[SAMPLE ? i : 0]; if (i >= 4) *(f32x2*)(P.out + O_CONVS + ((size_t)(layer * 128 + item) * 30 + (i - 4)) * CA + c) = x; }
            else { const float keep = (SAMPLE || i - 30 >= -t0) ? 1.f : 0.f; x = (f32x2){pg8::bf_lo(xr[i]) * keep, pg8::bf_hi(xr[i]) * keep}; }
#pragma unroll
            for (int t = 0; t < NT; ++t) { const int j = i - t; if (j >= 0 && j <= 30) o[t] = w[j] * x + o[t]; }
        }
        if (NT == 16) {
            float sv[32];
#pragma unroll
            for (int t = 0; t < 16; ++t) { const f32x2 v = o[t & (NT - 1)]; sv[t] = v.x + v.y; sv[16 + t] = v.x * v.x + v.y * v.y; }
            TR_STAGE(32, 16) TR_STAGE(16, 8) TR_STAGE(8, 4) TR_STAGE(4, 2) TR_STAGE(2, 1)
            sv[0] += __shfl_xor(sv[0], 1);
            if (!(lane & 1)) part[wave * 64 + (lane >> 1)] = sv[0];
        } else {
#pragma unroll
            for (int t = 0; t < NT; ++t) { const f32x2 v = o[t]; const float a = wave_sum(v.x + v.y), b = wave_sum(v.x * v.x + v.y * v.y); if (lane == 0) { part[wave * 64 + t] = a; part[wave * 64 + NT + t] = b; } }
        }
        __syncthreads();
        if (tid < 2 * NT) { float s = 0.f;
#pragma unroll
            for (int wv = 0; wv < 8; ++wv) s += part[wv * 64 + tid];
            tot[tid] = s; }
        __syncthreads();
#pragma unroll
        for (int t = 0; t < NT; ++t) {
            const float mean = tot[t] * (1.0f / 1024.0f), var = tot[NT + t] * (1.0f / 1024.0f) - mean * mean, rstd = 1.0f / sqrtf(fmaxf(var, 0.f) + EPS);
            const f32x2 a = (o[t] - mean) * rstd * lg + lb;
            *(unsigned*)(AACT + (size_t)(rowbase + t) * CA + c) = pk2(a.x * pg8::sigm(a.x), a.y * pg8::sigm(a.y));
        }
    }
}
__device__ __forceinline__ void mix_item(const Params& P, int layer, int item, LAS unsigned char* lds, int tid, int lane, int wave, bool dry = false, bool stats = true) {
    asm volatile("" : "+v"(tid), "+v"(lane));
    const int ck = item >> 3, g = item & 7, r0 = ck * 128;
    const bf16_t* V = (const bf16_t*)(P.ws + WS_V); bf16_t* U = (bf16_t*)(P.ws + WS_U); const float* vstat = (const float*)(P.ws + WS_VST);
    LAS float* st = (LAS float*)(lds + 4096); LAS bf16_t* vT = (LAS bf16_t*)(lds + 8192);
    constexpr int VP = 136;
    const int fr = lane & 15, fq = lane >> 4, t = 16 * wave + fr, nks = (wave >> 1) + 1;
    const float* wrow = P.in[15] + ((size_t)(layer * 8 + g) * 128 + t) * 128;
    f32x4 vs[12];
    if (stats && tid < 128) { const f32x4* p = (const f32x4*)(vstat + (size_t)(r0 + tid) * 48);
#pragma unroll
        for (int j = 0; j < 12; ++j) vs[j] = p[j]; }
    f32x4 wa[4], wb[4];
#pragma unroll
    for (int ks = 0; ks < 4; ++ks) if (ks < nks) { wa[ks] = *(const f32x4*)(wrow + 32 * ks + 8 * fq); wb[ks] = *(const f32x4*)(wrow + 32 * ks + 8 * fq + 4); }
    pg8::u32x2 uw[12];
#pragma unroll
    for (int cb = 0; cb < 12; ++cb) uw[cb] = *(const pg8::u32x2*)(U + (size_t)(r0 + t) * CB + g * 192 + 16 * cb + 4 * fq);
    const float bs = P.in[16][(layer * 8 + g) * 128 + t];
    const int q = tid >> 4, sp0 = tid & 15, ch = g * 192 + 8 * q;
    u32x4 va[4], vb[4]; f32x4 g0, g1, b0, b1;
    if (tid < 384) {
        g0 = *(const f32x4*)(P.in[13] + layer * CB + ch); g1 = *(const f32x4*)(P.in[13] + layer * CB + ch + 4);
        b0 = *(const f32x4*)(P.in[14] + layer * CB + ch); b1 = *(const f32x4*)(P.in[14] + layer * CB + ch + 4);
#pragma unroll
        for (int j = 0; j < 4; ++j) { const int s = 2 * (sp0 + 16 * j); va[j] = *(const u32x4*)(V + (size_t)(r0 + s) * CB + ch); vb[j] = *(const u32x4*)(V + (size_t)(r0 + s + 1) * CB + ch); } }
    __builtin_amdgcn_sched_barrier(0);
    if (stats && tid < 128) { float s1 = 0.f, s2 = 0.f;
#pragma unroll
        for (int j = 0; j < 12; ++j) { const f32x4 a = vs[j]; s1 += a[0] + a[2]; s2 += a[1] + a[3]; }
        const float mean = s1 * (1.0f / 1536.0f), var = s2 * (1.0f / 1536.0f) - mean * mean;
        st[2 * tid] = mean; st[2 * tid + 1] = 1.0f / sqrtf(fmaxf(var, 0.f) + EPS); }
    __syncthreads();
    const bool wr_v = (ck & 15) == 15; const int seq = ck >> 4;
    if (tid < 384) {
#pragma unroll
        for (int j = 0; j < 4; ++j) { const int s = 2 * (sp0 + 16 * j);
            f32x4 a0, a1, c0, c1; pg8::unpack8(va[j], a0, a1); pg8::unpack8(vb[j], c0, c1);
            const float m0 = st[2 * s], r0s = st[2 * s + 1], m1 = st[2 * s + 2], r1s = st[2 * s + 3];
            a0 = (a0 - m0) * r0s * g0 + b0; a1 = (a1 - m0) * r0s * g1 + b1; c0 = (c0 - m1) * r1s * g0 + b0; c1 = (c1 - m1) * r1s * g1 + b1;
            if (wr_v) { float* o = P.out + O_VP + ((size_t)(layer * 8 + seq) * 128 + s) * CB + ch; *(f32x4*)o = a0; *(f32x4*)(o + 4) = a1; *(f32x4*)(o + CB) = c0; *(f32x4*)(o + CB + 4) = c1; }
            LAS unsigned* d = (LAS unsigned*)(vT + (8 * q) * VP + s);
#pragma unroll
            for (int i = 0; i < 4; ++i) { d[i * (VP / 2)] = pk2(a0[i], c0[i]); d[(4 + i) * (VP / 2)] = pk2(a1[i], c1[i]); } }
    }
    __syncthreads();
    {
        f32x4 acc[12];
#pragma unroll
        for (int cb = 0; cb < 12; ++cb) acc[cb] = (f32x4){0.f, 0.f, 0.f, 0.f};
#pragma unroll
        for (int ks = 0; ks < 4; ++ks) if (ks < nks) { const int s0 = 32 * ks + 8 * fq;
            f32x4 xa = wa[ks], xb = wb[ks];
#pragma unroll
            for (int i = 0; i < 4; ++i) { if (s0 + i > t) xa[i] = 0.f; if (s0 + 4 + i > t) xb[i] = 0.f; }
            const u32x4 wp = pg8::pack8(xa, xb); const bf16x8 bfrag = __builtin_bit_cast(bf16x8, wp);
#pragma unroll
            for (int cb = 0; cb < 12; ++cb) { const bf16x8 afrag = *(const LAS bf16x8*)(vT + (16 * cb + fr) * VP + s0);
                acc[cb] = __builtin_amdgcn_mfma_f32_16x16x32_bf16(afrag, bfrag, acc[cb], 0, 0, 0); } }
#pragma unroll
        for (int cb = 0; cb < 12; ++cb) { bf16_t* up = U + (size_t)(r0 + t) * CB + g * 192 + 16 * cb + 4 * fq;
            const float m0 = (acc[cb][0] + bs) * pg8::bf_lo(uw[cb].x), m1 = (acc[cb][1] + bs) * pg8::bf_hi(uw[cb].x), m2 = (acc[cb][2] + bs) * pg8::bf_lo(uw[cb].y), m3 = (acc[cb][3] + bs) * pg8::bf_hi(uw[cb].y);
            if (!dry) *(pg8::u32x2*)up = (pg8::u32x2){pk2(m0, m1), pk2(m2, m3)}; else asm volatile("" :: "v"(m0 + m1 + m2 + m3)); }
    }
    __syncthreads();
}
__device__ __forceinline__ void mix_sample_item(const Params& P, int layer, int b, LAS unsigned char* lds, int tid) {
    const bf16_t* V = (const bf16_t*)(P.ws + WS_V); bf16_t* U = (bf16_t*)(P.ws + WS_U); const float* vstat = (const float*)(P.ws + WS_VST);
    LAS float* st = (LAS float*)(lds + 4096);
    asm volatile("" : "+v"(tid));
    const int r0 = MP + 4 * b;
    unsigned short vr[3][4], ur[3][4]; float lg[3], lb[3], wm[3][10], bsv[3][4];
#pragma unroll
    for (int j = 0; j < 3; ++j) { const int c = tid + 512 * j, g = c / 192;
        lg[j] = P.in[13][layer * CB + c]; lb[j] = P.in[14][layer * CB + c];
        const float* wg = P.in[15] + (size_t)(layer * 8 + g) * 128 * 128;
#pragma unroll
        for (int s = 0; s < 4; ++s) { vr[j][s] = V[(size_t)(r0 + s) * CB + c]; ur[j][s] = U[(size_t)(r0 + s) * CB + c]; bsv[j][s] = P.in[16][(layer * 8 + g) * 128 + s]; }
        int k = 0;
#pragma unroll
        for (int t = 0; t < 4; ++t)
#pragma unroll
            for (int s = 0; s <= t; ++s) wm[j][k++] = wg[t * 128 + s]; }
    if (tid < 4) { const f32x4* p = (const f32x4*)(vstat + (size_t)(r0 + tid) * 48); float s1 = 0.f, s2 = 0.f;
#pragma unroll
        for (int j = 0; j < 12; ++j) { const f32x4 a = p[j]; s1 += a[0] + a[2]; s2 += a[1] + a[3]; }
        const float mean = s1 * (1.0f / 1536.0f), var = s2 * (1.0f / 1536.0f) - mean * mean;
        st[2 * tid] = mean; st[2 * tid + 1] = 1.0f / sqrtf(fmaxf(var, 0.f) + EPS); }
    __syncthreads();
    __builtin_amdgcn_sched_barrier(0);
    float vl[3][4]; unsigned short ob[3][4];
#pragma unroll
    for (int j = 0; j < 3; ++j) {
#pragma unroll
        for (int s = 0; s < 4; ++s) vl[j][s] = (__uint_as_float((unsigned)vr[j][s] << 16) - st[2 * s]) * st[2 * s + 1] * lg[j] + lb[j];
        int k = 0;
#pragma unroll
        for (int t = 0; t < 4; ++t) { float m = bsv[j][t];
#pragma unroll
            for (int s = 0; s <= t; ++s) m += wm[j][k++] * vl[j][s];
            ob[j][t] = (unsigned short)(pk2(__uint_as_float((unsigned)ur[j][t] << 16) * m, 0.f) & 0xffffu); } }
    __builtin_amdgcn_sched_barrier(0);
#pragma unroll
    for (int j = 0; j < 3; ++j) { const int c = tid + 512 * j;
#pragma unroll
        for (int s = 0; s < 4; ++s) { P.out[O_VS + ((size_t)(layer * 128 + b) * 4 + s) * CB + c] = vl[j][s]; U[(size_t)(r0 + s) * CB + c] = ob[j][s]; } }
    __syncthreads();
}

#define XB_TMO      128
#define XB_XCNT(j)  (256  + 64 * (j))
#define XB_XSUB(j)  (1280 + 64 * (j))
#define XB_XGEN(j)  (2304 + 64 * (j))
#define XB_TOP      3328
#define XB_TOPGEN   3392
#define XCD_BAR_WORDS 3456
#define XB_SPIN_CAP (1u << 18)

__device__ __forceinline__ unsigned xb_ld(unsigned* p)              { return __hip_atomic_load(p, __ATOMIC_RELAXED, __HIP_MEMORY_SCOPE_AGENT); }
__device__ __forceinline__ unsigned xb_add(unsigned* p, unsigned v) { return __hip_atomic_fetch_add(p, v, __ATOMIC_RELAXED, __HIP_MEMORY_SCOPE_AGENT); }
__device__ __forceinline__ unsigned xb_xcc_id() { return (unsigned)__builtin_amdgcn_s_getreg((3 << 11) | 20) & 0xFu; }
#define XB_SPIN(cond, bar) do { unsigned _sp = 0; while (cond) { __builtin_amdgcn_s_sleep(1); \
    if ((++_sp & 255u) == 0u) { if (xb_ld(&(bar)[XB_TMO])) break; if (_sp > XB_SPIN_CAP) { atomicAdd(&(bar)[XB_TMO], 1u); break; } } } } while (0)

struct XcdBarrier {
    int wv;
    unsigned* bar; unsigned x;
    volatile LAS unsigned* st;
};

__device__ __forceinline__ XcdBarrier xcd_barrier_post(unsigned* bar, volatile LAS unsigned* st, int wv) {
    XcdBarrier b; b.wv = wv; b.bar = bar; b.x = xb_xcc_id(); b.st = st;
    if (wv == 0 && pg8::lane_now() == 0) (void)xb_add(&bar[XB_XCNT(b.x)], 1u);
    return b;
}
__device__ __forceinline__ void xcd_barrier_complete(unsigned* bar, unsigned x, unsigned& nloc, unsigned& nx) {
    const unsigned G = gridDim.x * gridDim.y * gridDim.z;
    unsigned sum, cnt, mine, sp = 0u;
    for (;;) {
        sum = 0u; cnt = 0u; mine = 0u;
#pragma unroll
        for (unsigned j = 0; j < 16; ++j) { const unsigned c = xb_ld(&bar[XB_XCNT(j)]); sum += c; cnt += (c > 0u) ? 1u : 0u; mine = (j == x) ? c : mine; }
        if (sum == G) break;
        __builtin_amdgcn_s_sleep(1);
        if ((++sp & 255u) == 0u) { if (xb_ld(&bar[XB_TMO])) break; if (sp > XB_SPIN_CAP) { atomicAdd(&bar[XB_TMO], 1u); break; } }
    }
    nloc = mine > 0u ? mine : 1u; nx = cnt > 0u ? cnt : 1u;
}

__device__ __forceinline__ void xcd_barrier(const XcdBarrier& b) {
    asm volatile("s_waitcnt vmcnt(0)" ::: "memory");
    __syncthreads();
    if (b.wv == 0 && pg8::lane_now() == 0) {
        unsigned* bar = b.bar;
        __builtin_amdgcn_s_waitcnt(0);
        unsigned nloc = b.st[0], nx = b.st[1];
        if (nloc == 0u) { xcd_barrier_complete(bar, b.x, nloc, nx); b.st[0] = nloc; b.st[1] = nx; }
        const unsigned old = xb_add(&bar[XB_XSUB(b.x)], 1u);
        const unsigned gen = old / nloc;
        if (old + 1u == (gen + 1u) * nloc) {
            __builtin_amdgcn_fence(__ATOMIC_RELEASE, "agent");
            asm volatile("s_waitcnt vmcnt(0)" ::: "memory");
            const unsigned og = xb_add(&bar[XB_TOP], 1u);
            const unsigned tg = og / nx;
            if (og + 1u == (tg + 1u) * nx) xb_add(&bar[XB_TOPGEN], 1u);
            else XB_SPIN(xb_ld(&bar[XB_TOPGEN]) == tg, bar);
            __builtin_amdgcn_fence(__ATOMIC_ACQUIRE, "agent");
            xb_add(&bar[XB_XGEN(b.x)], 1u);
            asm volatile("s_waitcnt vmcnt(0)" ::: "memory");
        } else {
            XB_SPIN(xb_ld(&bar[XB_XGEN(b.x)]) == gen, bar);
            __builtin_amdgcn_fence(__ATOMIC_ACQUIRE, "agent");
            asm volatile("s_waitcnt vmcnt(0)" ::: "memory");
        }
    }
    __syncthreads();
}

template <class Epi, bool NORED = false> __device__ __forceinline__ void gemm_mini(LAS unsigned char* lds, const bf16_t* A, const bf16_t* Bt, int N, int K, const Epi& E, int wave) {
    const int lane = pg8::lane_now(), fr = lane & 15, fq = lane >> 4;
    const int nmini = (N >> 8) * 16, G = gridDim.x, kw = K >> 3;
    for (int j = blockIdx.x; j < nmini; j += G) {
        const int wc = j & 3, wr = (j >> 2) & 1, pm = 64 + ((j >> 3) & 1), pn = j >> 4;
        f32x4 acc[2][2][4][2];
#pragma unroll
        for (int a = 0; a < 2; ++a)
#pragma unroll
            for (int b = 0; b < 2; ++b)
#pragma unroll
                for (int m = 0; m < 4; ++m)
#pragma unroll
                    for (int n = 0; n < 2; ++n) acc[a][b][m][n] = (f32x4){0.f, 0.f, 0.f, 0.f};
        const char* abase = (const char*)A + ((size_t)(pm * 256 + wr * 64) * K + (size_t)wave * kw) * 2;
        const char* bbase = (const char*)Bt + ((size_t)(pn * 256 + wc * 32) * K + (size_t)wave * kw) * 2;
        unsigned aoff = (unsigned)(fr * K + 8 * fq) * 2u, boff = (unsigned)((8 * (fr >> 2) + (fr & 3)) * K + 8 * fq) * 2u;
#pragma unroll 1
        for (int k0 = 0; k0 < kw; k0 += 32) {
            typedef const __attribute__((address_space(1))) bf16x8* gfrag_t;
            bf16x8 af[2][4], bf[2][2];
#pragma unroll
            for (int a = 0; a < 2; ++a)
#pragma unroll
                for (int m = 0; m < 4; ++m) af[a][m] = *(gfrag_t)(abase + (size_t)(a * 128 + m * 16) * K * 2 + aoff);
#pragma unroll
            for (int b = 0; b < 2; ++b)
#pragma unroll
                for (int n = 0; n < 2; ++n) bf[b][n] = *(gfrag_t)(bbase + (size_t)(b * 128 + 4 * n) * K * 2 + boff);
            __builtin_amdgcn_sched_barrier(0);
#pragma unroll
            for (int a = 0; a < 2; ++a)
#pragma unroll
                for (int b = 0; b < 2; ++b)
#pragma unroll
                    for (int m = 0; m < 4; ++m)
#pragma unroll
                        for (int n = 0; n < 2; ++n) acc[a][b][m][n] = __builtin_amdgcn_mfma_f32_16x16x32_bf16(bf[b][n], af[a][m], acc[a][b][m][n], 0, 0, 0);
            __builtin_amdgcn_sched_barrier(0);
            aoff += 64u; boff += 64u;
        }
#define MINI_IDX(a, b, m, n) (((((a) * 2 + (b)) * 4 + (m)) * 2 + (n)) * 1024)
#pragma unroll
        for (int half = NORED ? 0 : 4; half >= 1; half >>= 1) {
            if (wave >= half && wave < 2 * half) { const unsigned sa = (unsigned)(wave - half) * 32768u + (unsigned)lane * 16u;
#pragma unroll
                for (int a = 0; a < 2; ++a)
#pragma unroll
                    for (int b = 0; b < 2; ++b)
#pragma unroll
                        for (int m = 0; m < 4; ++m)
#pragma unroll
                            for (int n = 0; n < 2; ++n) asm volatile("ds_write_b128 %0, %1 offset:%2" :: "v"(sa), "v"(acc[a][b][m][n]), "n"(MINI_IDX(a, b, m, n)) : "memory");
                asm volatile("s_waitcnt lgkmcnt(0)" ::: "memory"); }
            __syncthreads();
            if (wave < half) { const unsigned sa = (unsigned)wave * 32768u + (unsigned)lane * 16u;
#pragma unroll
                for (int a = 0; a < 2; ++a)
#pragma unroll
                    for (int b = 0; b < 2; ++b) { f32x4 t0, t1, t2, t3, t4, t5, t6, t7;
                        asm volatile("ds_read_b128 %0, %8 offset:%9\n\tds_read_b128 %1, %8 offset:%10\n\tds_read_b128 %2, %8 offset:%11\n\tds_read_b128 %3, %8 offset:%12\n\t"
                                     "ds_read_b128 %4, %8 offset:%13\n\tds_read_b128 %5, %8 offset:%14\n\tds_read_b128 %6, %8 offset:%15\n\tds_read_b128 %7, %8 offset:%16\n\ts_waitcnt lgkmcnt(0)"
                                     : "=&v"(t0), "=&v"(t1), "=&v"(t2), "=&v"(t3), "=&v"(t4), "=&v"(t5), "=&v"(t6), "=&v"(t7)
                                     : "v"(sa), "n"(MINI_IDX(a, b, 0, 0)), "n"(MINI_IDX(a, b, 0, 1)), "n"(MINI_IDX(a, b, 1, 0)), "n"(MINI_IDX(a, b, 1, 1)),
                                       "n"(MINI_IDX(a, b, 2, 0)), "n"(MINI_IDX(a, b, 2, 1)), "n"(MINI_IDX(a, b, 3, 0)), "n"(MINI_IDX(a, b, 3, 1)) : "memory");
                        acc[a][b][0][0] += t0; acc[a][b][0][1] += t1; acc[a][b][1][0] += t2; acc[a][b][1][1] += t3;
                        acc[a][b][2][0] += t4; acc[a][b][2][1] += t5; acc[a][b][3][0] += t6; acc[a][b][3][1] += t7; } }
            __syncthreads();
        }
#undef MINI_IDX
        if (wave == 0) { pg8::Unit u{pm, pn}; E(acc, u, wr, wc, fr, fq); }
    }
}
template <class Epi, int AI, int MH2> __device__ __forceinline__ void mini32_unit(LAS unsigned char* lds, const char* abase, const char* bbase, int K, int kw, const Epi& E, int wave, int lane, int pm, int pn, int wr, int wc) {
    typedef const __attribute__((address_space(1))) bf16x8* gfrag_t;
    const int fr = lane & 15, fq = lane >> 4;
    f32x4 acc[2][2][4][2];
#pragma unroll
    for (int b = 0; b < 2; ++b)
#pragma unroll
        for (int mm = 0; mm < 2; ++mm)
#pragma unroll
            for (int n = 0; n < 2; ++n) acc[AI][b][2 * MH2 + mm][n] = (f32x4){0.f, 0.f, 0.f, 0.f};
    unsigned aoff = (unsigned)(fr * K + 8 * fq) * 2u, boff = (unsigned)((8 * (fr >> 2) + (fr & 3)) * K + 8 * fq) * 2u;
#pragma unroll 1
    for (int k0 = 0; k0 < kw; k0 += 32) {
        bf16x8 af[2], bf[2][2];
#pragma unroll
        for (int mm = 0; mm < 2; ++mm) af[mm] = *(gfrag_t)(abase + (size_t)(AI * 128 + (2 * MH2 + mm) * 16) * K * 2 + aoff);
#pragma unroll
        for (int b = 0; b < 2; ++b)
#pragma unroll
            for (int n = 0; n < 2; ++n) bf[b][n] = *(gfrag_t)(bbase + (size_t)(b * 128 + 4 * n) * K * 2 + boff);
        __builtin_amdgcn_sched_barrier(0);
#pragma unroll
        for (int b = 0; b < 2; ++b)
#pragma unroll
            for (int mm = 0; mm < 2; ++mm)
#pragma unroll
                for (int n = 0; n < 2; ++n) acc[AI][b][2 * MH2 + mm][n] = __builtin_amdgcn_mfma_f32_16x16x32_bf16(bf[b][n], af[mm], acc[AI][b][2 * MH2 + mm][n], 0, 0, 0);
        __builtin_amdgcn_sched_barrier(0);
        aoff += 64u; boff += 64u;
    }
#define M32_IDX(b, mm, n) ((((b) * 2 + (mm)) * 2 + (n)) * 1024)
#pragma unroll
    for (int half = 4; half >= 1; half >>= 1) {
        if (wave >= half && wave < 2 * half) { const unsigned sa = (unsigned)(wave - half) * 8192u + (unsigned)lane * 16u;
#pragma unroll
            for (int b = 0; b < 2; ++b)
#pragma unroll
                for (int mm = 0; mm < 2; ++mm)
#pragma unroll
                    for (int n = 0; n < 2; ++n) asm volatile("ds_write_b128 %0, %1 offset:%2" :: "v"(sa), "v"(acc[AI][b][2 * MH2 + mm][n]), "n"(M32_IDX(b, mm, n)) : "memory");
            asm volatile("s_waitcnt lgkmcnt(0)" ::: "memory"); }
        __syncthreads();
        if (wave < half) { const unsigned sa = (unsigned)wave * 8192u + (unsigned)lane * 16u; f32x4 t0, t1, t2, t3, t4, t5, t6, t7;
            asm volatile("ds_read_b128 %0, %8 offset:%9\n\tds_read_b128 %1, %8 offset:%10\n\tds_read_b128 %2, %8 offset:%11\n\tds_read_b128 %3, %8 offset:%12\n\t"
                         "ds_read_b128 %4, %8 offset:%13\n\tds_read_b128 %5, %8 offset:%14\n\tds_read_b128 %6, %8 offset:%15\n\tds_read_b128 %7, %8 offset:%16\n\ts_waitcnt lgkmcnt(0)"
                         : "=&v"(t0), "=&v"(t1), "=&v"(t2), "=&v"(t3), "=&v"(t4), "=&v"(t5), "=&v"(t6), "=&v"(t7)
                         : "v"(sa), "n"(M32_IDX(0, 0, 0)), "n"(M32_IDX(0, 0, 1)), "n"(M32_IDX(0, 1, 0)), "n"(M32_IDX(0, 1, 1)),
                           "n"(M32_IDX(1, 0, 0)), "n"(M32_IDX(1, 0, 1)), "n"(M32_IDX(1, 1, 0)), "n"(M32_IDX(1, 1, 1)) : "memory");
            acc[AI][0][2 * MH2][0] += t0; acc[AI][0][2 * MH2][1] += t1; acc[AI][0][2 * MH2 + 1][0] += t2; acc[AI][0][2 * MH2 + 1][1] += t3;
            acc[AI][1][2 * MH2][0] += t4; acc[AI][1][2 * MH2][1] += t5; acc[AI][1][2 * MH2 + 1][0] += t6; acc[AI][1][2 * MH2 + 1][1] += t7; }
        __syncthreads();
    }
#undef M32_IDX
    if (wave == 0) { pg8::Unit u{pm, pn}; E.template operator()<AI, AI + 1, 2 * MH2, 2 * MH2 + 2>(acc, u, wr, wc, fr, fq); }
}
template <class Epi> __device__ __forceinline__ void gemm_mini64(LAS unsigned char* lds, const bf16_t* A, const bf16_t* Bt, int N, int K, const Epi& E, int wave) {
    const int lane = pg8::lane_now();
    const int nmini = (N >> 8) * 64, G = gridDim.x, kw = K >> 3;
    for (int j = blockIdx.x; j < nmini; j += G) {
        const int wc = j & 3, wr = (j >> 2) & 1, mh = (j >> 3) & 1, ai = (j >> 4) & 1, pm = 64 + ((j >> 5) & 1), pn = j >> 6;
        const char* abase = (const char*)A + ((size_t)(pm * 256 + wr * 64) * K + (size_t)wave * kw) * 2;
        const char* bbase = (const char*)Bt + ((size_t)(pn * 256 + wc * 32) * K + (size_t)wave * kw) * 2;
        if (ai == 0) { if (mh == 0) mini32_unit<Epi, 0, 0>(lds, abase, bbase, K, kw, E, wave, lane, pm, pn, wr, wc); else mini32_unit<Epi, 0, 1>(lds, abase, bbase, K, kw, E, wave, lane, pm, pn, wr, wc); }
        else { if (mh == 0) mini32_unit<Epi, 1, 0>(lds, abase, bbase, K, kw, E, wave, lane, pm, pn, wr, wc); else mini32_unit<Epi, 1, 1>(lds, abase, bbase, K, kw, E, wave, lane, pm, pn, wr, wc); }
    }
}
template <class Epi, bool SMALLN = false> __device__ __forceinline__ void run_gemm(LAS unsigned char* lds, const bf16_t* A, const bf16_t* Bt, int N, int K, const Epi& E, int wv) {
    asm volatile("" : "+s"(K)); asm volatile("" : "+s"(N));
    pg8::Gemm g{A, Bt, MP, N, K}; pg8::StaticOrder S; S.init(MP, N, (int)gridDim.x, (int)blockIdx.x);
    const bool mini_first = ((blockIdx.x >> 3) & 1) != 0;
#pragma unroll 1
    for (int pass = 0; pass < 2; ++pass) {
        if ((pass == 0) == mini_first) { if constexpr (SMALLN) gemm_mini64<Epi>(lds, A, Bt, N, K, E, wv); else gemm_mini<Epi>(lds, A, Bt, N, K, E, wv); }
        if (pass == 0) pg8::gemm_phase<Epi, pg8::StaticOrder, true, true>(lds, g, S, E, wv);
    }
#if (MK_PROBE & 1)
    { pg8::EpiNop EN; pg8::gemm_phase<pg8::EpiNop, pg8::StaticOrder, true, true>(lds, g, S, EN, wv); }
#endif
#if (MK_PROBE & 2)
    { pg8::EpiNop EN; gemm_mini<pg8::EpiNop, (MK_PROBE & 32) != 0>(lds, A, Bt, N, K, EN, wv); }
#endif
}

__global__ void __launch_bounds__(NTHR, 2) mega_fwd(Params P) {
    extern __shared__ __attribute__((aligned(16))) unsigned char lds_raw[];
    LAS unsigned char* lds = (LAS unsigned char*)lds_raw;
    cg::grid_group grid = cg::this_grid();
    const int lo = P.ph_lo, hi = P.ph_hi;
    volatile LAS unsigned* MISC = (volatile LAS unsigned*)(lds + LDS_BYTES - 128);
    int wv = __builtin_amdgcn_readfirstlane(threadIdx.x >> 6); asm volatile("" : "+s"(wv));
    if (wv == 0) { const int l0 = pg8::lane_now(); if (l0 < 32) MISC[l0] = 0u; }
    __syncthreads();
    XcdBarrier bar = xcd_barrier_post((unsigned*)(P.ws + WS_CTL), MISC + 8, wv);
#define IN(k) (lo <= (k) && (k) < hi)
#define SEAM(k) do { if (IN(k) && IN((k) + 1)) { if ((k) == 0) grid.sync(); else xcd_barrier(bar); } } while (0)
#define PHASE_PROLOGUE \
    unsigned char* ws = P.ws; asm volatile("" : "+s"(ws)); \
    const int lane = pg8::lane_now(), wave = wv, G = gridDim.x; int tid = wave * 64 + lane; \
    const int gw = blockIdx.x * NWAVES + wave, ngw = G * NWAVES; (void)tid; \
    bf16_t* XB = (bf16_t*)(ws + WS_XB); bf16_t* PB = (bf16_t*)(ws + WS_PB); bf16_t* U = (bf16_t*)(ws + WS_U); bf16_t* GLU = (bf16_t*)(ws + WS_GLU); bf16_t* V = (bf16_t*)(ws + WS_V); \
    bf16_t* H = (bf16_t*)(ws + WS_H); bf16_t* GA = (bf16_t*)(ws + WS_GA); bf16_t* GB = (bf16_t*)(ws + WS_GB); \
    float* SSA = (float*)(ws + WS_SSA); float* SSB = (float*)(ws + WS_SSB); float* VST = (float*)(ws + WS_VST); \
    (void)lane; (void)gw; (void)ngw; (void)XB; (void)PB; (void)U; (void)GLU; (void)V; (void)H; (void)GA; (void)GB; (void)SSA; (void)SSB; (void)VST; (void)G;

    if (IN(0)) { PHASE_PROLOGUE convert(P, 0, 0x3ffu, lds, gw, ngw, lane); x_to_bf16(P, gw, ngw, lane); }
    SEAM(0);
    for (int l = 0; l < 2; ++l) {
        const int pb = 1 + 7 * l;
        if (IN(pb + 0)) { PHASE_PROLOGUE
            pg8::EpiIn E0{(const float*)(ws + WS_BIN), SSA, GLU, U, V, GA, GB, VST, P.out, l};
#if (MK_PROBE & 16)
            pg8::EpiTwice<pg8::EpiIn> E{E0};
#else
            const pg8::EpiIn& E = E0;
#endif
            run_gemm(lds, XB, (const bf16_t*)(ws + WS_WIN), DIN, DM, E, wave);
            if (l == 1) convert(P, 1, 1u << 6, lds, gw, ngw, lane);
        }
        SEAM(pb + 0);
        if (IN(pb + 1)) { PHASE_PROLOGUE
            if (G == 256) {
                const int i0 = (blockIdx.x & 7) * 128 + (blockIdx.x >> 3) * 4;
                for (int k = 0; k < 4; ++k) mix_item(P, l, i0 + k, lds, tid, lane, wave, false, k == 0);
                conv_items<16, false>(P, l, lds, tid, lane, wave, i0, i0 + 4, 1);
            } else {
                for (int it = blockIdx.x; it < 1024; it += G) mix_item(P, l, it, lds, tid, lane, wave);
                const int ipc = (1024 + G - 1) / G, i0 = blockIdx.x * ipc;
                conv_items<16, false>(P, l, lds, tid, lane, wave, i0, (i0 + ipc < 1024 ? i0 + ipc : 1024), 1);
            }
            conv_items<4, true>(P, l, lds, tid, lane, wave, blockIdx.x, 128, G);
            for (int it = (blockIdx.x + G - (G >> 1)) % G; it < 128; it += G) mix_sample_item(P, l, it, lds, tid);
#if (MK_PROBE & 4)
            for (int it = blockIdx.x; it < 1024; it += G) mix_item(P, l, it, lds, tid, lane, wave, true);
            conv_items<16, false>(P, l, lds, tid, lane, wave, blockIdx.x, 1024, G);
            conv_items<4, true>(P, l, lds, tid, lane, wave, blockIdx.x, 128, G);
#endif
            if (l == 0) convert(P, 1, 1u | 256u, lds, gw, ngw, lane);
        }
        SEAM(pb + 1);
        if (IN(pb + 2)) { PHASE_PROLOGUE
            { pg8::EpiMul<0> E{GA, nullptr, nullptr, DM}; run_gemm<pg8::EpiMul<0>, true>(lds, (const bf16_t*)P.out, (const bf16_t*)(ws + WS_WA), DM, CA, E, wave); }
            { pg8::EpiMul<1> E{GB, GA, nullptr, DM}; run_gemm<pg8::EpiMul<1>, true>(lds, U, (const bf16_t*)(ws + WS_WB), DM, CB, E, wave); }
        }
        SEAM(pb + 2);
        if (IN(pb + 3)) { PHASE_PROLOGUE
            pg8::EpiRes<false> E{XB, XB, SSA, nullptr, nullptr, nullptr};
            run_gemm<pg8::EpiRes<false>, true>(lds, GB, (const bf16_t*)(ws + WS_WO), DM, DM, E, wave);
            if (l == 0) convert(P, 1, (1u << 1) | (1u << 2), lds, gw, ngw, lane);
        }
        SEAM(pb + 3);
        if (IN(pb + 4)) { PHASE_PROLOGUE
            { pg8::EpiMul<2> E{GA, nullptr, nullptr, DM}; run_gemm<pg8::EpiMul<2>, true>(lds, PB, (const bf16_t*)(ws + WS_WPE), DM, PDIM, E, wave); }
#if (MK_PROBE & 16)
            { pg8::EpiTwice<pg8::EpiMul<3>> E{{H, nullptr, SSA, DFF}}; run_gemm(lds, XB, (const bf16_t*)(ws + WS_W1), DFF, DM, E, wave); }
#else
            { pg8::EpiMul<3> E{H, nullptr, SSA, DFF}; run_gemm(lds, XB, (const bf16_t*)(ws + WS_W1), DFF, DM, E, wave); }
#endif
            if (l == 0) convert(P, 1, 1u << 3, lds, gw, ngw, lane);
        }
        SEAM(pb + 4);
        if (IN(pb + 5)) { PHASE_PROLOGUE
            pg8::EpiRes<false> E{XB, GB, SSB, nullptr, nullptr, nullptr};
            run_gemm<pg8::EpiRes<false>, true>(lds, H, (const bf16_t*)(ws + WS_W2), DM, DFF, E, wave);
            if (l == 0) convert(P, 1, (1u << 4) | (1u << 7) | 512u, lds, gw, ngw, lane);
        }
        SEAM(pb + 5);
        if (IN(pb + 6)) { PHASE_PROLOGUE
            pg8::EpiRes<true> E{GB, XB, SSA, SSB, P.in[25] + l * DM, GA};
            run_gemm<pg8::EpiRes<true>, true>(lds, GB, (const bf16_t*)(ws + WS_WPG), DM, DM, E, wave);
            if (l == 0) convert(P, 1, 1u << 5, lds, gw, ngw, lane);
        }
        SEAM(pb + 6);
    }
    if (IN(15)) { PHASE_PROLOGUE final_norm(P, gw, ngw, lane); }
#undef IN
#undef SEAM
#undef PHASE_PROLOGUE
}

#ifndef MK_PER_PHASE
#define MK_PER_PHASE 0
#endif
extern "C" void kernel_launch(void* const* d_in, const int* in_sizes, int n_in, void* d_out, int out_size, void* d_ws, size_t ws_size, hipStream_t stream) {
    static int grid = 0;
    if (grid == 0) {
        if (n_in != 27 || out_size != 30375936 || ws_size < WS_END) { fprintf(stderr, "kernel_launch: unexpected sizes n_in %d out %d ws %zu (need %zu)\n", n_in, out_size, ws_size, (size_t)WS_END); grid = -1; return; }
        int dev = 0, cus = 0, per_cu = 0;
        hipGetDevice(&dev); hipDeviceGetAttribute(&cus, hipDeviceAttributeMultiprocessorCount, dev);
        if (hipFuncSetAttribute((const void*)mega_fwd, hipFuncAttributeMaxDynamicSharedMemorySize, LDS_BYTES) != hipSuccess) { fprintf(stderr, "hipFuncSetAttribute failed\n"); grid = -1; return; }
        if (hipOccupancyMaxActiveBlocksPerMultiprocessor(&per_cu, (const void*)mega_fwd, NTHR, LDS_BYTES) != hipSuccess || per_cu < 1) { fprintf(stderr, "occupancy query: %d\n", per_cu); (void)hipGetLastError(); per_cu = 1; }
        grid = cus;
        fprintf(stderr, "kernel_launch: grid %d (per_cu %d), ws %zu need %zu\n", grid, per_cu, ws_size, (size_t)WS_END);
    }
    if (grid < 0) return;
    if (hipMemsetAsync((char*)d_ws + WS_CTL, 0, 65536, stream) != hipSuccess) { fprintf(stderr, "memset failed\n"); return; }
    Params p{};
    for (int i = 0; i < 27; ++i) p.in[i] = (const float*)d_in[i];
    p.out = (float*)d_out; p.ws = (unsigned char*)d_ws;
#if MK_PER_PHASE
    for (int k = 0; k < 16; ++k) { p.ph_lo = k; p.ph_hi = k + 1; hipLaunchKernelGGL(mega_fwd, dim3(grid), dim3(NTHR), LDS_BYTES, stream, p); }
#else
    p.ph_lo = 0; p.ph_hi = 16;
    void* args[] = {&p};
    hipError_t e = hipLaunchCooperativeKernel((const void*)mega_fwd, dim3(grid), dim3(NTHR), args, LDS_BYTES, stream);
    if (e != hipSuccess) fprintf(stderr, "cooperative launch failed: %s (grid %d)\n", hipGetErrorString(e), grid);
#endif
}
```

```cpp
#include <hip/hip_runtime.h>
#include <hip/hip_cooperative_groups.h>
#include <cstdio>
#include <cstdint>
namespace cg = cooperative_groups;
namespace pg8 {
#define PG8_LAS __attribute__((address_space(3)))
typedef unsigned short bf16_t;
typedef short bf16x8 __attribute__((ext_vector_type(8)));
typedef float f32x4 __attribute__((ext_vector_type(4)));
typedef unsigned u32x4 __attribute__((ext_vector_type(4)));
__device__ __forceinline__ int lane_now() { int l; asm volatile("v_mbcnt_lo_u32_b32 %0, -1, 0\n\tv_mbcnt_hi_u32_b32 %0, -1, %0" : "=v"(l)); return l & 63; }
constexpr int BM = 256, BK = 64, HALF = 128, HTB = HALF * BK * 2  , STAGE_BYTES = 8 * HTB, NXCD = 8, WGM = 8;

__host__ __device__ __forceinline__ int lds_byte(int r, int c) { const int st = (r >> 4) * 2 + (c >> 5), rr = r & 15, cc = c & 31, ob = rr * 64 + cc * 2; return st * 1024 + (ob ^ (((ob >> 9) & 1) << 5)); }
__host__ __device__ __forceinline__ void stage_rc(int b, int& R, int& C) { const int st = b / 1024, sb = b % 1024, swz = sb ^ (((sb >> 9) & 1) << 5); R = (st >> 1) * 16 + swz / 64; C = (st & 1) * 32 + (swz % 64) / 2; }
__host__ __device__ __forceinline__ int perm32(int rho) { const int n = rho >> 4, i = rho & 15; return 8 * (i >> 2) + 4 * n + (i & 3); }

struct Unit { int pm, pn; };
struct Gemm { const bf16_t* A; const bf16_t* Bt; int M, N, K; };

struct StaticOrder {
    int nM, nN, nwg, G, c;
    __host__ __device__ void init(int M, int N, int G_, int c_) { nM = M / BM; nN = N / BM; nwg = nM * nN; G = G_; c = c_; }
    __host__ __device__ bool next(int i, Unit& u) const {
        const long L = (long)i * G + c; if (L >= nwg) return false;
        int wgid = (int)L; { const int q = nwg / NXCD, r = nwg % NXCD, xcd = wgid % NXCD, off = wgid / NXCD; wgid = (xcd < r ? xcd * (q + 1) : r * (q + 1) + (xcd - r) * q) + off; }
        const int nig = WGM * nN, gid = wgid / nig, fm = gid * WGM, gsz = (nM - fm) < WGM ? (nM - fm) : WGM;
        u.pm = fm + ((wgid % nig) % gsz); u.pn = (wgid % nig) / gsz; return true;
    }
    __device__ __forceinline__ void a_ready(const Unit&) const {}
    __device__ __forceinline__ void done(const Unit&) const {}
};

__device__ __forceinline__ unsigned cvt_pk_bf16(float lo, float hi) { unsigned r; asm volatile("v_cvt_pk_bf16_f32 %0, %1, %2" : "=v"(r) : "v"(lo), "v"(hi)); return r; }
typedef float f32x2 __attribute__((ext_vector_type(2)));
__device__ __forceinline__ f32x2 gelu_pk(f32x2 v) {
    const f32x2 av = __builtin_elementwise_abs(v), d = av * 0.2316418882f + 1.0f;
    f32x2 t; t.x = __builtin_amdgcn_rcpf(d.x); t.y = __builtin_amdgcn_rcpf(d.y);
    f32x2 q = t * 0.5307027145f + (-0.7265760135f); q = q * t + 0.7107068705f; q = q * t + (-0.142248368f); q = q * t + 0.127414796f; q = q * t;
    const f32x2 s = (v * v) * (-0.72134752044f);
    f32x2 e; e.x = __builtin_amdgcn_exp2f(s.x); e.y = __builtin_amdgcn_exp2f(s.y);
    const f32x2 m = v * (q * e), r = v - m;
    f32x2 o; o.x = v.x < 0.f ? m.x : r.x; o.y = v.y < 0.f ? m.y : r.y; return o;
}
typedef unsigned u32x2 __attribute__((ext_vector_type(2)));
constexpr int MP = 16384, MS = 512, MT = MP + MS;
constexpr long O_Y = 0, O_CONVP = 17301504, O_CONVS = 17793024, O_VP = 25657344, O_VS = 28803072;
__device__ __forceinline__ float bf_lo(unsigned w) { return __uint_as_float(w << 16); }
__device__ __forceinline__ float bf_hi(unsigned w) { return __uint_as_float(w & 0xffff0000u); }
__device__ __forceinline__ float sigm(float x) { return __builtin_amdgcn_rcpf(1.f + __builtin_amdgcn_exp2f(-1.44269504f * x)); }
__device__ __forceinline__ float gelu_t(float x) { const float y = 0.7978845608f * (x + 0.044715f * x * x * x); return x * __builtin_amdgcn_rcpf(1.f + __builtin_amdgcn_exp2f(-2.88539008f * y)); }
__device__ __forceinline__ u32x4 pack8(const f32x4 a, const f32x4 b) { u32x4 w; w.x = cvt_pk_bf16(a[0], a[1]); w.y = cvt_pk_bf16(a[2], a[3]); w.z = cvt_pk_bf16(b[0], b[1]); w.w = cvt_pk_bf16(b[2], b[3]); return w; }
__device__ __forceinline__ void unpack8(const u32x4 w, f32x4& a, f32x4& b) { a = (f32x4){bf_lo(w.x), bf_hi(w.x), bf_lo(w.y), bf_hi(w.y)}; b = (f32x4){bf_lo(w.z), bf_hi(w.z), bf_lo(w.w), bf_hi(w.w)}; }
__device__ __forceinline__ float sum4(const f32x4 a) { return (a[0] + a[1]) + (a[2] + a[3]); }
__device__ __forceinline__ float ssq4(const f32x4 a) { return (a[0] * a[0] + a[1] * a[1]) + (a[2] * a[2] + a[3] * a[3]); }
__device__ __forceinline__ void row_rs(const float* ssq, int rowt  , int fr, int fq, float (&rs)[2][4]) {
    float t[2];
#pragma unroll
    for (int j = 0; j < 2; ++j) { const int r = rowt + 128 * (fq >> 1) + 16 * (2 * (fq & 1) + j) + fr; const f32x4* p = (const f32x4*)(ssq + (size_t)r * 16);
        const f32x4 a = (p[0] + p[1]) + (p[2] + p[3]); t[j] = 1.0f / sqrtf(sum4(a) * (1.0f / 1024.0f) + 1e-6f); }
#pragma unroll
    for (int ai = 0; ai < 2; ++ai)
#pragma unroll
        for (int m = 0; m < 4; ++m) rs[ai][m] = __shfl(t[m & 1], fr + 16 * (ai * 2 + (m >> 1)));
}
__device__ __forceinline__ void st16_async(void* p, u32x4 v) { asm volatile("global_store_dwordx4 %0, %1, off\n\ts_nop 1" :: "v"(p), "v"(v) : "memory"); }
__device__ __forceinline__ void st4_async(void* p, float v) { asm volatile("global_store_dword %0, %1, off\n\ts_nop 0" :: "v"(p), "v"(v) : "memory"); }
#define EPI_ROW(ai, m) (u.pm * BM + (ai) * HALF + wr * 64 + (m) * 16 + fr)

struct EpiIn {
    static constexpr bool PERM = true, AFTER_DRAIN = false;
    const float* bias; const float* ssq; bf16_t* GLU; bf16_t* U; bf16_t* V; bf16_t* GA; bf16_t* GB; float* vstat; float* out; int layer;
    template <int AIL = 0, int AIH = 2> __device__ __forceinline__ void operator()(const f32x4 (&acc)[2][2][4][2], const Unit& u, int wr, int wc, int fr, int fq) const {
        float rs[2][4]; row_rs(ssq, u.pm * BM + wr * 64, fr, fq, rs);
        const int cb = u.pn * BM + wc * 32 + 8 * fq;
        const f32x4 b00 = *(const f32x4*)(bias + cb), b01 = *(const f32x4*)(bias + cb + 4), b10 = *(const f32x4*)(bias + cb + HALF), b11 = *(const f32x4*)(bias + cb + HALF + 4);
        if (u.pn < 8) {
            const int ch = u.pn * 128 + wc * 32 + 8 * fq;
#pragma unroll
            for (int ai = AIL; ai < AIH; ++ai)
#pragma unroll
                for (int m = 0; m < 4; ++m) { __builtin_amdgcn_sched_barrier(0); const int row = EPI_ROW(ai, m); const float r = rs[ai][m];
                    const f32x4 a0 = acc[ai][0][m][0] * r + b00, a1 = acc[ai][0][m][1] * r + b01, g0 = acc[ai][1][m][0] * r + b10, g1 = acc[ai][1][m][1] * r + b11;
                    f32x4 o0, o1;
#pragma unroll
                    for (int i = 0; i < 4; ++i) { o0[i] = a0[i] * sigm(g0[i]); o1[i] = a1[i] * sigm(g1[i]); }
                    *(u32x4*)(GLU + (size_t)row * 1024 + ch) = pack8(o0, o1);
                    if (row < MP) { const int tt = row & 2047; if (tt >= 2018) { float* o = out + O_CONVP + ((size_t)(layer * 8 + (row >> 11)) * 30 + (tt - 2018)) * 1024 + ch; *(f32x4*)o = o0; *(f32x4*)(o + 4) = o1; } }
                    else { const int sr = row - MP; float* o = out + O_CONVS + ((size_t)(layer * 128 + (sr >> 2)) * 30 + 26 + (sr & 3)) * 1024 + ch; *(f32x4*)o = o0; *(f32x4*)(o + 4) = o1; } }
        } else if (u.pn < 20) {
            const bool isv = u.pn >= 14; bf16_t* base = isv ? V : U; const int ct = (u.pn - (isv ? 14 : 8)) * BM + wc * 32 + 8 * fq;
#pragma unroll
            for (int ai = AIL; ai < AIH; ++ai)
#pragma unroll
                for (int m = 0; m < 4; ++m) { __builtin_amdgcn_sched_barrier(0); const int row = EPI_ROW(ai, m); const float r = rs[ai][m]; float s1 = 0.f, s2 = 0.f;
#pragma unroll
                    for (int bj = 0; bj < 2; ++bj) { f32x4 z0 = acc[ai][bj][m][0] * r + (bj ? b10 : b00), z1 = acc[ai][bj][m][1] * r + (bj ? b11 : b01);
#pragma unroll
                        for (int i = 0; i < 4; ++i) { z0[i] = gelu_t(z0[i]); z1[i] = gelu_t(z1[i]); }
                        s1 += sum4(z0) + sum4(z1); s2 += ssq4(z0) + ssq4(z1);
                        *(u32x4*)(base + (size_t)row * 1536 + ct + bj * HALF) = pack8(z0, z1); }
                    if (isv) { s1 += __shfl_xor(s1, 16); s1 += __shfl_xor(s1, 32); s2 += __shfl_xor(s2, 16); s2 += __shfl_xor(s2, 32);
                        if (fq == 0) *(f32x2*)(vstat + ((size_t)row * 24 + (u.pn - 14) * 4 + wc) * 2) = (f32x2){s1, s2}; } }
        } else {
            const int ch = (u.pn - 20) * 128 + wc * 32 + 8 * fq;
#pragma unroll
            for (int ai = AIL; ai < AIH; ++ai)
#pragma unroll
                for (int m = 0; m < 4; ++m) { __builtin_amdgcn_sched_barrier(0); const int row = EPI_ROW(ai, m); const float r = rs[ai][m];
                    f32x4 a0 = acc[ai][0][m][0] * r + b00, a1 = acc[ai][0][m][1] * r + b01, g0 = acc[ai][1][m][0] * r + b10, g1 = acc[ai][1][m][1] * r + b11;
#pragma unroll
                    for (int i = 0; i < 4; ++i) { a0[i] = sigm(a0[i]); a1[i] = sigm(a1[i]); g0[i] = sigm(g0[i]); g1[i] = sigm(g1[i]); }
                    *(u32x4*)(GA + (size_t)row * 1024 + ch) = pack8(a0, a1); *(u32x4*)(GB + (size_t)row * 1024 + ch) = pack8(g0, g1); }
        }
    }
};
template <int MODE> struct EpiMul {
    static constexpr bool PERM = true, AFTER_DRAIN = false;
    bf16_t* G; const bf16_t* G2; const float* ssq; int ldc;
    template <int AIL = 0, int AIH = 2, int ML = 0, int MH = 4> __device__ __forceinline__ void operator()(const f32x4 (&acc)[2][2][4][2], const Unit& u, int wr, int wc, int fr, int fq) const {
        float rs[2][4];
        if (MODE == 3) row_rs(ssq, u.pm * BM + wr * 64, fr, fq, rs);
        const size_t cb = (size_t)u.pn * BM + wc * 32 + 8 * fq;
        constexpr int NB = ((MODE == 1) ? 2 : 4) < (MH - ML) ? ((MODE == 1) ? 2 : 4) : (MH - ML);
#pragma unroll
        for (int it0 = 4 * AIL + ML; it0 < 4 * (AIH - 1) + MH; it0 += NB) {
            u32x4 ga[NB][2], gb[NB][2];
            if (MODE == 0 || MODE == 1) {
#pragma unroll
                for (int k = 0; k < NB; ++k)
#pragma unroll
                    for (int bj = 0; bj < 2; ++bj) { const size_t off = (size_t)EPI_ROW((it0 + k) >> 2, (it0 + k) & 3) * ldc + cb + bj * HALF; ga[k][bj] = *(const u32x4*)(G + off); if (MODE == 1) gb[k][bj] = *(const u32x4*)(G2 + off); }
                __builtin_amdgcn_sched_barrier(0); }
#pragma unroll
            for (int k = 0; k < NB; ++k) { const int ai = (it0 + k) >> 2, m = (it0 + k) & 3; const int row = EPI_ROW(ai, m);
#pragma unroll
                for (int bj = 0; bj < 2; ++bj) { const size_t off = (size_t)row * ldc + cb + bj * HALF;
                    f32x4 v0 = acc[ai][bj][m][0], v1 = acc[ai][bj][m][1];
                    if (MODE == 0 || MODE == 1) { f32x4 g0, g1; unpack8(ga[k][bj], g0, g1); v0 = v0 * g0; v1 = v1 * g1; }
                    if (MODE == 1) { f32x4 g0, g1; unpack8(gb[k][bj], g0, g1); v0 = v0 + g0; v1 = v1 + g1; }
                    if (MODE == 3) { const float r2 = rs[ai][m] * rs[ai][m];
#pragma unroll
                        for (int i = 0; i < 4; ++i) { const float a = fmaxf(v0[i], 0.f), b = fmaxf(v1[i], 0.f); v0[i] = a * a * r2; v1[i] = b * b * r2; } }
                    *(u32x4*)(G + off) = pack8(v0, v1); }
                __builtin_amdgcn_sched_barrier(0); }
        }
    }
};
template <bool PLE> struct EpiRes {
    static constexpr bool PERM = true, AFTER_DRAIN = false;
    const bf16_t* XS; bf16_t* XO; float* ssq_out; const float* ssq_in; const float* bias; const bf16_t* PE;
    template <int AIL = 0, int AIH = 2, int ML = 0, int MH = 4> __device__ __forceinline__ void operator()(const f32x4 (&acc)[2][2][4][2], const Unit& u, int wr, int wc, int fr, int fq) const {
        float rs[2][4];
        if (PLE) row_rs(ssq_in, u.pm * BM + wr * 64, fr, fq, rs);
        const int cb = u.pn * BM + wc * 32 + 8 * fq;
        f32x4 bb[2][2];
        if (PLE) {
#pragma unroll
            for (int bj = 0; bj < 2; ++bj) { bb[bj][0] = *(const f32x4*)(bias + cb + bj * HALF); bb[bj][1] = *(const f32x4*)(bias + cb + bj * HALF + 4); } }
        constexpr int NB = (PLE ? 2 : 4) < (MH - ML) ? (PLE ? 2 : 4) : (MH - ML);
#pragma unroll
        for (int it0 = 4 * AIL + ML; it0 < 4 * (AIH - 1) + MH; it0 += NB) {
            u32x4 xa[NB][2], pa[NB][2];
#pragma unroll
            for (int k = 0; k < NB; ++k)
#pragma unroll
                for (int bj = 0; bj < 2; ++bj) { const size_t off = (size_t)EPI_ROW((it0 + k) >> 2, (it0 + k) & 3) * 1024 + cb + bj * HALF; xa[k][bj] = *(const u32x4*)(XS + off); if (PLE) pa[k][bj] = *(const u32x4*)(PE + off); }
            __builtin_amdgcn_sched_barrier(0);
#pragma unroll
            for (int k = 0; k < NB; ++k) { const int ai = (it0 + k) >> 2, m = (it0 + k) & 3; const int row = EPI_ROW(ai, m); float ss = 0.f;
#pragma unroll
                for (int bj = 0; bj < 2; ++bj) { const size_t off = (size_t)row * 1024 + cb + bj * HALF;
                    f32x4 v0 = acc[ai][bj][m][0], v1 = acc[ai][bj][m][1];
                    if (PLE) { f32x4 p0, p1; unpack8(pa[k][bj], p0, p1); const float r = rs[ai][m];
#pragma unroll
                        for (int i = 0; i < 4; ++i) { v0[i] = sigm(v0[i] * r + bb[bj][0][i]) * p0[i]; v1[i] = sigm(v1[i] * r + bb[bj][1][i]) * p1[i]; } }
                    f32x4 x0, x1; unpack8(xa[k][bj], x0, x1); x0 = x0 + v0; x1 = x1 + v1;
                    *(u32x4*)(XO + off) = pack8(x0, x1);
                    ss += ssq4(x0) + ssq4(x1); }
                ss += __shfl_xor(ss, 16); ss += __shfl_xor(ss, 32);
                if (fq == 0) ssq_out[(size_t)row * 16 + u.pn * 4 + wc] = ss;
                __builtin_amdgcn_sched_barrier(0); }
        }
    }
};

struct EpiNop {
    static constexpr bool PERM = true, AFTER_DRAIN = false;
    template <int AIL = 0, int AIH = 2> __device__ __forceinline__ void operator()(const f32x4 (&acc)[2][2][4][2], const Unit&, int, int, int, int) const {
#pragma unroll
        for (int a = AIL; a < AIH; ++a)
#pragma unroll
            for (int b = 0; b < 2; ++b)
#pragma unroll
                for (int mm = 0; mm < 4; ++mm)
#pragma unroll
                    for (int n = 0; n < 2; ++n) asm volatile("" :: "v"(acc[a][b][mm][n]));
    }
};

template <class E0> struct EpiTwice {
    static constexpr bool PERM = true, AFTER_DRAIN = false;
    E0 e;
    template <int AIL = 0, int AIH = 2> __device__ __forceinline__ void operator()(const f32x4 (&acc)[2][2][4][2], const Unit& u, int wr, int wc, int fr, int fq) const { e.template operator()<AIL, AIH>(acc, u, wr, wc, fr, fq); asm volatile("" ::: "memory"); e.template operator()<AIL, AIH>(acc, u, wr, wc, fr, fq); }
};
template <class Epi, class Sched, bool ALIGN_EPI = false, bool SP2 = false>
__device__ __forceinline__ void gemm_phase(PG8_LAS unsigned char* lds, const Gemm g, const Sched& S, const Epi& E, int wv  ) {
    int tid_ = wv * 64 + lane_now();
    const int tid = tid_, wid = __builtin_amdgcn_readfirstlane(tid >> 6), lane = tid & 63, wr = wid >> 2, wc = wid & 3, fr = lane & 15, fq = lane >> 4;
    const int K = g.K, nt = K / BK;
    unsigned voffA[2], voffB[2];
#pragma unroll
    for (int i = 0; i < 2; ++i) { int R, C; stage_rc(tid * 16 + i * 8192, R, C); const int Rb = Epi::PERM ? ((R & ~31) + perm32(R & 31)) : R;
        voffA[i] = (unsigned)(R * K + C) * 2u; voffB[i] = (unsigned)(Rb * K + C) * 2u; }
    const size_t kstep = (size_t)(BK * 2);
    const size_t hstep = (size_t)HALF * K * 2;
    const size_t tstep = 2 * hstep;
    const unsigned ldsw = (unsigned)wid * 1024u;
    const int aoff = lds_byte(wr * 64 + fr, fq * 8), boff = lds_byte(wc * 32 + fr, fq * 8);
#define PG8_SA(b, h) (((b) * 2 + (h)) * HTB)
#define PG8_SB(b, h) ((4 + (b) * 2 + (h)) * HTB)
#define PG8_STAGE(bufoff, gbase, voff) do { _Pragma("unroll") for (int _i = 0; _i < 2; ++_i) \
        __builtin_amdgcn_global_load_lds((const unsigned*)((const char*)(gbase) + (voff)[_i]), (PG8_LAS unsigned*)(lds + (bufoff) + ldsw + _i * 8192), 16, 0, 0); } while (0)
#define PG8_LDA(dst, b, h) do { _Pragma("unroll") for (int m = 0; m < 4; ++m) _Pragma("unroll") for (int k = 0; k < 2; ++k) dst[m][k] = *(const PG8_LAS bf16x8*)(lds + PG8_SA(b, h) + aoff + m * 2048 + k * 1024); } while (0)
#define PG8_LDB(dst, b, h) do { _Pragma("unroll") for (int n = 0; n < 2; ++n) _Pragma("unroll") for (int k = 0; k < 2; ++k) dst[n][k] = *(const PG8_LAS bf16x8*)(lds + PG8_SB(b, h) + boff + n * 2048 + k * 1024); } while (0)
#define PG8_MMA(ai, bj, At, Bt) do { __builtin_amdgcn_s_setprio(1); _Pragma("unroll") for (int m = 0; m < 4; ++m) _Pragma("unroll") for (int n = 0; n < 2; ++n) _Pragma("unroll") for (int k = 0; k < 2; ++k) \
        acc[ai][bj][m][n] = __builtin_amdgcn_mfma_f32_16x16x32_bf16(Bt[n][k], At[m][k], acc[ai][bj][m][n], 0, 0, 0); __builtin_amdgcn_s_setprio(0); } while (0)
#define PG8_WAIT_V(n) asm volatile("s_waitcnt vmcnt(" #n ")" ::: "memory")
#define PG8_WAIT_L(n) asm volatile("s_waitcnt lgkmcnt(" #n ")" ::: "memory")
#define PG8_BAR __builtin_amdgcn_s_barrier()
#define PG8_SCHED __builtin_amdgcn_sched_barrier(0)
    Unit cur, nxt; int ui = 0;
    if (!S.next(0, cur)) return;
    f32x4 acc[2][2][4][2];
#pragma unroll
    for (int a = 0; a < 2; ++a)
#pragma unroll
        for (int b = 0; b < 2; ++b)
#pragma unroll
            for (int m = 0; m < 4; ++m)
#pragma unroll
                for (int n = 0; n < 2; ++n) acc[a][b][m][n] = (f32x4){0.f, 0.f, 0.f, 0.f};
    bf16x8 At[4][2], B0[2][2], B1[2][2];
    const char* cA = (const char*)g.A + (size_t)cur.pm * tstep; const char* cB = (const char*)g.Bt + (size_t)cur.pn * tstep;
    S.a_ready(cur);
    if constexpr (SP2) {
        PG8_STAGE(PG8_SB(0, 0), cB, voffB); PG8_STAGE(PG8_SB(0, 1), cB + hstep, voffB); PG8_STAGE(PG8_SA(0, 0), cA, voffA); PG8_STAGE(PG8_SA(0, 1), cA + hstep, voffA);
        if (wr == 1) PG8_BAR;
        PG8_WAIT_V(2); PG8_BAR;
        PG8_STAGE(PG8_SB(1, 0), cB + kstep, voffB); PG8_STAGE(PG8_SA(1, 0), cA + kstep, voffA); PG8_STAGE(PG8_SB(1, 1), cB + hstep + kstep, voffB);
        PG8_WAIT_V(6); PG8_BAR;
    } else {
        PG8_STAGE(PG8_SB(0, 0), cB, voffB); PG8_STAGE(PG8_SA(0, 0), cA, voffA); PG8_STAGE(PG8_SB(0, 1), cB + hstep, voffB); PG8_STAGE(PG8_SA(0, 1), cA + hstep, voffA);
        if (wr == 1) PG8_BAR;
        PG8_WAIT_V(4); PG8_BAR;
        PG8_STAGE(PG8_SB(1, 0), cB + kstep, voffB); PG8_STAGE(PG8_SA(1, 0), cA + kstep, voffA); PG8_STAGE(PG8_SB(1, 1), cB + hstep + kstep, voffB);
        PG8_WAIT_V(6); PG8_BAR;
    }
    for (;;) {
        const bool has_next = S.next(ui + 1, nxt);
        const char* nA = has_next ? (const char*)g.A + (size_t)nxt.pm * tstep : cA; const char* nB = has_next ? (const char*)g.Bt + (size_t)nxt.pn * tstep : cB;
        for (int t = 0; t < nt; t += 2) {
            const bool last = (t == nt - 2);
            const char* a1 = cA + (size_t)(t + 1) * kstep;
            const char* a2 = last ? nA : cA + (size_t)(t + 2) * kstep; const char* b2 = last ? nB : cB + (size_t)(t + 2) * kstep;
            const char* a3 = a2 + kstep; const char* b3 = b2 + kstep;
            if (last && has_next) S.a_ready(nxt);
            if constexpr (SP2) {
            PG8_LDB(B0, 0, 0); PG8_LDB(B1, 0, 1); PG8_SCHED; PG8_LDA(At, 0, 0); PG8_STAGE(PG8_SA(1, 1), a1 + hstep, voffA);
            PG8_WAIT_V(8); PG8_WAIT_L(0); PG8_BAR; PG8_MMA(0, 0, At, B0); PG8_MMA(0, 1, At, B1); PG8_BAR; PG8_SCHED;
            PG8_LDA(At, 0, 1); PG8_STAGE(PG8_SB(0, 0), b2, voffB); PG8_STAGE(PG8_SB(0, 1), b2 + hstep, voffB); PG8_STAGE(PG8_SA(0, 0), a2, voffA);
            PG8_WAIT_V(8); PG8_WAIT_L(0); PG8_BAR; PG8_MMA(1, 0, At, B0); PG8_MMA(1, 1, At, B1); PG8_BAR; PG8_SCHED;
            PG8_LDB(B0, 1, 0); PG8_LDB(B1, 1, 1); PG8_SCHED; PG8_LDA(At, 1, 0); PG8_STAGE(PG8_SA(0, 1), a2 + hstep, voffA);
            PG8_WAIT_V(8); PG8_WAIT_L(0); PG8_BAR; PG8_MMA(0, 0, At, B0); PG8_MMA(0, 1, At, B1); PG8_BAR; PG8_SCHED;
            PG8_LDA(At, 1, 1); PG8_STAGE(PG8_SB(1, 0), b3, voffB); PG8_STAGE(PG8_SB(1, 1), b3 + hstep, voffB); PG8_STAGE(PG8_SA(1, 0), a3, voffA);
            PG8_WAIT_V(8); PG8_WAIT_L(0); PG8_BAR; PG8_MMA(1, 0, At, B0); PG8_MMA(1, 1, At, B1); PG8_BAR; PG8_SCHED;
            } else {
            PG8_LDB(B0, 0, 0); PG8_SCHED; PG8_LDA(At, 0, 0); PG8_STAGE(PG8_SA(1, 1), a1 + hstep, voffA);
            PG8_WAIT_L(8); PG8_BAR; PG8_WAIT_L(0); PG8_MMA(0, 0, At, B0); PG8_BAR; PG8_SCHED;
            PG8_LDB(B1, 0, 1); PG8_STAGE(PG8_SB(0, 0), b2, voffB);
            PG8_BAR; PG8_WAIT_L(0); PG8_MMA(0, 1, At, B1); PG8_BAR;
            PG8_LDA(At, 0, 1); PG8_STAGE(PG8_SA(0, 0), a2, voffA);
            PG8_BAR; PG8_WAIT_L(0); PG8_MMA(1, 0, At, B0); PG8_BAR; PG8_SCHED;
            PG8_STAGE(PG8_SB(0, 1), b2 + hstep, voffB);
            PG8_WAIT_V(6); PG8_BAR; PG8_MMA(1, 1, At, B1); PG8_BAR;
            PG8_LDB(B0, 1, 0); PG8_SCHED; PG8_LDA(At, 1, 0); PG8_STAGE(PG8_SA(0, 1), a2 + hstep, voffA);
            PG8_WAIT_L(8); PG8_BAR; PG8_WAIT_L(0); PG8_MMA(0, 0, At, B0); PG8_BAR; PG8_SCHED;
            PG8_LDB(B1, 1, 1); PG8_STAGE(PG8_SB(1, 0), b3, voffB);
            PG8_BAR; PG8_WAIT_L(0); PG8_MMA(0, 1, At, B1); PG8_BAR;
            PG8_LDA(At, 1, 1); PG8_STAGE(PG8_SA(1, 0), a3, voffA);
            PG8_BAR; PG8_WAIT_L(0); PG8_MMA(1, 0, At, B0); PG8_BAR; PG8_SCHED;
            PG8_STAGE(PG8_SB(1, 1), b3 + hstep, voffB);
            PG8_WAIT_V(6); PG8_BAR; PG8_MMA(1, 1, At, B1); PG8_BAR;
            }
        }
        if constexpr (ALIGN_EPI) { if (wr == 0) PG8_BAR; }
        if constexpr (!Epi::AFTER_DRAIN) { E(acc, cur, wr, wc, fr, fq); S.done(cur); }
        if (!has_next) break;
#pragma unroll
        for (int a = 0; a < 2; ++a)
#pragma unroll
            for (int b = 0; b < 2; ++b)
#pragma unroll
                for (int m = 0; m < 4; ++m)
#pragma unroll
                    for (int n = 0; n < 2; ++n) acc[a][b][m][n] = (f32x4){0.f, 0.f, 0.f, 0.f};
        cur = nxt; cA = nA; cB = nB; ++ui;
        if constexpr (ALIGN_EPI) { if (wr == 1) PG8_BAR; }
    }
    PG8_WAIT_V(0);
    if constexpr (!ALIGN_EPI) { if (wr == 0) PG8_BAR; }
    PG8_BAR;
    if constexpr (Epi::AFTER_DRAIN) { E.fused(acc, cur, wr, wc, fr, fq, lds, wid, lane); S.done(cur); }
#undef PG8_SA
#undef PG8_SB
#undef PG8_STAGE
#undef PG8_LDA
#undef PG8_LDB
#undef PG8_MMA
#undef PG8_WAIT_V
#undef PG8_WAIT_L
#undef PG8_BAR
#undef PG8_SCHED
}
}

#ifndef MK_PROBE
#define MK_PROBE 0
#endif
#define LAS __attribute__((address_space(3)))
using pg8::bf16_t; using pg8::f32x4; using pg8::f32x2; using pg8::u32x4; using pg8::bf16x8; using pg8::MP; using pg8::MS; using pg8::MT;
using pg8::O_CONVP; using pg8::O_CONVS; using pg8::O_VP; using pg8::O_VS;
constexpr int NWAVES = 8, NTHR = 512;
constexpr int LDS_BYTES = 147456;
constexpr int DM = 1024, CA = 1024, CB = 1536, DIN = 7168, DFF = 4096, PDIM = 256;
constexpr float EPS = 1e-6f;
constexpr size_t al256(size_t x) { return (x + 255) & ~(size_t)255; }
constexpr size_t WS_CTL = 0;
constexpr size_t WS_WIN = 65536;
constexpr size_t WS_WA = WS_WIN + (size_t)DIN * DM * 2;
constexpr size_t WS_WB = WS_WA + (size_t)DM * CA * 2;
constexpr size_t WS_WO = WS_WB + (size_t)DM * CB * 2;
constexpr size_t WS_W1 = WS_WO + (size_t)DM * DM * 2;
constexpr size_t WS_W2 = WS_W1 + (size_t)DFF * DM * 2;
constexpr size_t WS_WPG = WS_W2 + (size_t)DM * DFF * 2;
constexpr size_t WS_WPE = WS_WPG + (size_t)DM * DM * 2;
constexpr size_t WS_BIN = WS_WPE + (size_t)DM * PDIM * 2;
constexpr size_t WS_XB = WS_BIN + (size_t)DIN * 4;
constexpr size_t WS_PB = WS_XB + (size_t)MT * DM * 2;
constexpr size_t WS_U = WS_PB + (size_t)MT * PDIM * 2;
constexpr size_t WS_GLU = WS_U + (size_t)MT * CB * 2;
constexpr size_t WS_V = WS_GLU + (size_t)MT * CA * 2;
constexpr size_t WS_H = WS_U;
constexpr size_t WS_GA = WS_V + (size_t)MT * CB * 2;
constexpr size_t WS_GB = WS_GA + (size_t)MT * DM * 2;
constexpr size_t WS_SSA = WS_GB + (size_t)MT * DM * 2;
constexpr size_t WS_SSB = WS_SSA + (size_t)MT * 16 * 4;
constexpr size_t WS_VST = WS_SSB + (size_t)MT * 16 * 4;
constexpr size_t WS_END = WS_VST + (size_t)MT * 48 * 4;
static_assert(WS_H + (size_t)MT * DFF * 2 == WS_GA, "h overlays u|glu|v exactly");
static_assert(WS_END <= 302395392, "d_ws map must fit sum(inputs) bytes");

struct Params { const float* in[27]; float* out; unsigned char* ws; int ph_lo, ph_hi; };

__device__ __forceinline__ float wave_sum(float v) {
#pragma unroll
    for (int o = 1; o < 64; o <<= 1) v += __shfl_xor(v, o);
    return v;
}
__device__ __forceinline__ unsigned pk2(float lo, float hi) { return pg8::cvt_pk_bf16(lo, hi); }

__device__ __forceinline__ void tr_load(f32x4 (&v)[8], const float* W, int Nsrc, int srccol0, int k0, int lane) {
#pragma unroll
    for (int i = 0; i < 8; ++i) { const int kk = 8 * i + (lane >> 3); v[i] = __builtin_nontemporal_load((const f32x4*)(W + (size_t)(k0 + kk) * Nsrc + srccol0 + 4 * (lane & 7))); }
}
__device__ __forceinline__ void tr_finish(const f32x4 (&v)[8], int K, const float* gain, bf16_t* WT, int n0, int k0, LAS float* scr, int lane) {
#pragma unroll
    for (int i = 0; i < 8; ++i) { const int kk = 8 * i + (lane >> 3); f32x4 x = v[i]; if (gain) x = x * gain[k0 + kk];
        LAS float* d = scr + kk * 33 + 4 * (lane & 7); d[0] = x[0]; d[1] = x[1]; d[2] = x[2]; d[3] = x[3]; }
    asm volatile("s_waitcnt lgkmcnt(0)" ::: "memory");
    const int c = lane & 7;
#pragma unroll
    for (int j = 0; j < 4; ++j) { const int n = (lane >> 3) + 8 * j; const LAS float* s = scr + (8 * c) * 33 + n;
        u32x4 o; o.x = pk2(s[0 * 33], s[1 * 33]); o.y = pk2(s[2 * 33], s[3 * 33]); o.z = pk2(s[4 * 33], s[5 * 33]); o.w = pk2(s[6 * 33], s[7 * 33]);
        pg8::st16_async(WT + (size_t)(n0 + n) * K + k0 + 8 * c, o); }
    asm volatile("s_waitcnt lgkmcnt(0)" ::: "memory");
}
__device__ __forceinline__ int win_src(int n) {
    if (n < 2048) return ((n >> 7) & 1) * 1024 + 128 * (n >> 8) + (n & 127);
    if (n < 5120) return n;
    const int n2 = n - 5120; return 5120 + ((n2 >> 7) & 1) * 1024 + 128 * (n2 >> 8) + (n2 & 127);
}
__device__ __forceinline__ void convert1(const Params& P, int layer, unsigned mask, LAS unsigned char* lds, int gw, int ngw, int lane) {
    lane = pg8::lane_now();
    const int wv_ = gw & 7;
    LAS float* scr = (LAS float*)(lds + 65536 + wv_ * 8448);
    unsigned char* ws = P.ws;
    const int  Ks[8] = {1024, 1024, 1536, 1024, 1024, 4096, 1024, 256};
    const int  Ns[8] = {7168, 1024, 1024, 1024, 4096, 1024, 1024, 1024};
#pragma unroll
    for (int id = 0; id < 8; ++id) {
        if (!(mask & (1u << id))) continue;
        const int K = Ks[id], N = Ns[id];
        const float* W; const float* gain = nullptr; bf16_t* WT;
        switch (id) {
            case 0: W = P.in[6] + (size_t)layer * DM * DIN; gain = P.in[5] + layer * DM; WT = (bf16_t*)(ws + WS_WIN); break;
            case 1: W = P.in[12] + (size_t)layer * CA * DM; WT = (bf16_t*)(ws + WS_WA); break;
            case 2: W = P.in[17] + (size_t)layer * CB * DM; WT = (bf16_t*)(ws + WS_WB); break;
            case 3: W = P.in[18] + (size_t)layer * DM * DM; WT = (bf16_t*)(ws + WS_WO); break;
            case 4: W = P.in[20] + (size_t)layer * DM * DFF; gain = P.in[19] + layer * DM; WT = (bf16_t*)(ws + WS_W1); break;
            case 5: W = P.in[21] + (size_t)layer * DFF * DM; WT = (bf16_t*)(ws + WS_W2); break;
            case 6: W = P.in[24] + (size_t)layer * DM * DM; gain = P.in[22] + layer * DM; WT = (bf16_t*)(ws + WS_WPG); break;
            default: W = P.in[23] + (size_t)layer * PDIM * DM; WT = (bf16_t*)(ws + WS_WPE); break;
        }
        const int nblk = N / 32, nitems = (K / 64) * nblk;
        {   f32x4 va[8], vb[8]; int it = gw;
            if (it < nitems) { const int n0 = 32 * (it % nblk); tr_load(va, W, N, id == 0 ? win_src(n0) : n0, 64 * (it / nblk), lane); }
            for (; it < nitems; it += 2 * ngw) {
                const int i1 = it + ngw, i2 = it + 2 * ngw;
                if (i1 < nitems) { const int n0 = 32 * (i1 % nblk); tr_load(vb, W, N, id == 0 ? win_src(n0) : n0, 64 * (i1 / nblk), lane); }
                __builtin_amdgcn_sched_barrier(0);
                tr_finish(va, K, gain, WT, 32 * (it % nblk), 64 * (it / nblk), scr, lane);
                __builtin_amdgcn_sched_barrier(0);
                if (i1 < nitems) {
                    if (i2 < nitems) { const int n0 = 32 * (i2 % nblk); tr_load(va, W, N, id == 0 ? win_src(n0) : n0, 64 * (i2 / nblk), lane); }
                    __builtin_amdgcn_sched_barrier(0);
                    tr_finish(vb, K, gain, WT, 32 * (i1 % nblk), 64 * (i1 / nblk), scr, lane);
                    __builtin_amdgcn_sched_barrier(0);
                }
            }
        }
    }
    if (mask & 256u) {
        float* binp = (float*)(ws + WS_BIN); const float* b_in = P.in[7] + layer * DIN;
        for (int i = gw * 64 + lane; i < DIN; i += ngw * 64) binp[i] = b_in[win_src(i)];
    }
    if (mask & 512u) {
        bf16_t* PB = (bf16_t*)(ws + WS_PB);
        for (int r = gw; r < MT; r += ngw) {
            const float* src = r < MP ? P.in[3] + ((size_t)layer * MP + r) * PDIM : P.in[4] + ((size_t)layer * MS + (r - MP)) * PDIM;
            const f32x4 v = __builtin_nontemporal_load((const f32x4*)src + lane);
            ((pg8::u32x2*)(PB + (size_t)r * PDIM))[lane] = (pg8::u32x2){pk2(v[0], v[1]), pk2(v[2], v[3])}; }
    }
}
__device__ __forceinline__ void convert(const Params& P, int layer, unsigned mask, LAS unsigned char* lds, int gw, int ngw, int lane) {
    convert1(P, layer, mask, lds, gw, ngw, lane);
#if (MK_PROBE & 8)
    convert1(P, layer, mask, lds, gw, ngw, lane);
#endif
}
__device__ __forceinline__ void x_to_bf16(const Params& P, int gw, int ngw, int lane) {
    bf16_t* XB = (bf16_t*)(P.ws + WS_XB); float* ssq = (float*)(P.ws + WS_SSA);
    const bool xl = (ngw == 2048);
    const int wl = (blockIdx.x >> 3) * 8 + (gw & 7), rb = (blockIdx.x & 7) * 2048 + 8 * wl;
    for (int q2 = 0; q2 < (xl ? 5 : 1 << 30); ++q2) {
        int r;
        if (xl) { if (q2 < 4) r = rb + 2 * q2; else { r = MP + 2 * gw; if (r >= MT) break; } } else { r = 2 * gw + q2 * 2 * ngw; if (r >= MT) break; }
        f32x4 v[2][4];
#pragma unroll
        for (int q = 0; q < 2; ++q) { const int rr = r + q; const float* src = rr < MP ? P.in[0] + (size_t)rr * DM : P.in[1] + (size_t)(rr - MP) * DM;
#pragma unroll
            for (int j = 0; j < 4; ++j) v[q][j] = __builtin_nontemporal_load((const f32x4*)src + lane + 64 * j); }
        __builtin_amdgcn_sched_barrier(0);
#pragma unroll
        for (int q = 0; q < 2; ++q) { const int rr = r + q; float s = 0.f;
#pragma unroll
            for (int j = 0; j < 4; ++j) { s += pg8::ssq4(v[q][j]); ((pg8::u32x2*)(XB + (size_t)rr * DM))[lane + 64 * j] = (pg8::u32x2){pk2(v[q][j][0], v[q][j][1]), pk2(v[q][j][2], v[q][j][3])}; }
            s = wave_sum(s);
            if (lane < 16) ssq[(size_t)rr * 16 + lane] = lane == 0 ? s : 0.f; }
    }
}
__device__ __forceinline__ void final_norm(const Params& P, int gw, int ngw, int lane) {
    const float* ssq = (const float*)(P.ws + WS_SSA); const float* g = P.in[26]; const bf16_t* XB = (const bf16_t*)(P.ws + WS_XB);
    f32x4 gg[4];
#pragma unroll
    for (int j = 0; j < 2; ++j) { const int c4 = 2 * (lane + 64 * j); gg[2 * j] = ((const f32x4*)g)[c4]; gg[2 * j + 1] = ((const f32x4*)g)[c4 + 1]; }
    const bool xl = (ngw == 2048);
    const int wl = (blockIdx.x >> 3) * 8 + (gw & 7), rb = (blockIdx.x & 7) * 2048 + 8 * wl;
    for (int q2 = 0; q2 < (xl ? 5 : 1 << 30); ++q2) {
        int r;
        if (xl) { if (q2 < 4) r = rb + 2 * q2; else { r = MP + 2 * gw; if (r >= MT) break; } } else { r = 2 * gw + q2 * 2 * ngw; if (r >= MT) break; }
        u32x4 xv[2][2]; float sv[2];
#pragma unroll
        for (int q = 0; q < 2; ++q) { const u32x4* xr = (const u32x4*)(XB + (size_t)(r + q) * DM); xv[q][0] = xr[lane]; xv[q][1] = xr[lane + 64]; sv[q] = lane < 16 ? ssq[(size_t)(r + q) * 16 + lane] : 0.f; }
        __builtin_amdgcn_sched_barrier(0);
#pragma unroll
        for (int q = 0; q < 2; ++q) { const float rs = 1.0f / sqrtf(wave_sum(sv[q]) * (1.0f / 1024.0f) + EPS); f32x4* row = (f32x4*)(P.out + (size_t)(r + q) * DM);
#pragma unroll
            for (int j = 0; j < 2; ++j) { f32x4 a, b; pg8::unpack8(xv[q][j], a, b); const int c4 = 2 * (lane + 64 * j); row[c4] = a * rs * gg[2 * j]; row[c4 + 1] = b * rs * gg[2 * j + 1]; } }
    }
}

#define TR_STAGE(B, N) { const bool up = (lane & (B)) != 0; _Pragma("unroll") for (int i = 0; i < (N); ++i) { const float keep = up ? sv[i + (N)] : sv[i]; const float send = up ? sv[i] : sv[i + (N)]; sv[i] = keep + __shfl_xor(send, (B)); } }
template <int NT, bool SAMPLE>
__device__ __forceinline__ void conv_items(const Params& P, int layer, LAS unsigned char* lds, int tid, int lane, int wave, int first, int nitems, int stride) {
    const bf16_t* GLU = (const bf16_t*)(P.ws + WS_GLU); bf16_t* AACT = (bf16_t*)P.out;
    LAS float* part = (LAS float*)lds; LAS float* tot = (LAS float*)(lds + 2048);
    const int c = 2 * tid;
    const float* cw = P.in[8] + (size_t)layer * 31 * CA + c;
    f32x2 w[31];
#pragma unroll
    for (int j = 0; j < 31; ++j) w[j] = *(const f32x2*)(cw + j * CA);
    const f32x2 cb = *(const f32x2*)(P.in[9] + layer * CA + c);
    const f32x2 lg = *(const f32x2*)(P.in[10] + layer * CA + c), lb = *(const f32x2*)(P.in[11] + layer * CA + c);
    unsigned xr[NT + 30];
#pragma unroll 1
    for (int item = first; item < nitems; item += stride) {
        f32x2 o[NT];
#pragma unroll
        for (int t = 0; t < NT; ++t) o[t] = cb;
        int rowbase, t0 = 64;
        if (!SAMPLE) { t0 = (item & 127) * 16; rowbase = (item >> 7) * 2048 + t0; } else rowbase = MP + 4 * item;
        f32x2 xs[SAMPLE ? 30 : 1];
        if (SAMPLE || stride != 1 || item == first || (item & 127) == 0) {
#pragma unroll
            for (int i = 0; i < NT + 30; ++i) {
                if (SAMPLE && i < 30) xs[SAMPLE ? i : 0] = *(const f32x2*)(P.in[2] + ((size_t)(layer * 128 + item) * 30 + i) * CA + c);
                else { const int di = (SAMPLE || i - 30 >= -t0) ? i - 30 : -t0;
                    xr[i] = *(const unsigned*)(GLU + (size_t)(rowbase + di) * CA + c); }
            }
        } else {
#pragma unroll
            for (int i = 0; i < 30; ++i) xr[i] = xr[i + NT];
#pragma unroll
            for (int k = 0; k < NT; ++k) xr[30 + k] = *(const unsigned*)(GLU + (size_t)(rowbase + k) * CA + c);
        }
        __builtin_amdgcn_sched_barrier(0);
#pragma unroll
        for (int i = 0; i < NT + 30; ++i) {
            f32x2 x;
            if (SAMPLE && i < 30) { x = xs[SAMPLE ? i : 0]; if (i >= 4) *(f32x2*)(P.out + O_CONVS + ((size_t)(layer * 128 + item) * 30 + (i - 4)) * CA + c) = x; }
            else { const float keep = (SAMPLE || i - 30 >= -t0) ? 1.f : 0.f; x = (f32x2){pg8::bf_lo(xr[i]) * keep, pg8::bf_hi(xr[i]) * keep}; }
#pragma unroll
            for (int t = 0; t < NT; ++t) { const int j = i - t; if (j >= 0 && j <= 30) o[t] = w[j] * x + o[t]; }
        }
        if (NT == 16) {
            float sv[32];
#pragma unroll
            for (int t = 0; t < 16; ++t) { const f32x2 v = o[t & (NT - 1)]; sv[t] = v.x + v.y; sv[16 + t] = v.x * v.x + v.y * v.y; }
            TR_STAGE(32, 16) TR_STAGE(16, 8) TR_STAGE(8, 4) TR_STAGE(4, 2) TR_STAGE(2, 1)
            sv[0] += __shfl_xor(sv[0], 1);
            if (!(lane & 1)) part[wave * 64 + (lane >> 1)] = sv[0];
        } else {
#pragma unroll
            for (int t = 0; t < NT; ++t) { const f32x2 v = o[t]; const float a = wave_sum(v.x + v.y), b = wave_sum(v.x * v.x + v.y * v.y); if (lane == 0) { part[wave * 64 + t] = a; part[wave * 64 + NT + t] = b; } }
        }
        __syncthreads();
        if (tid < 2 * NT) { float s = 0.f;
#pragma unroll
            for (int wv = 0; wv < 8; ++wv) s += part[wv * 64 + tid];
            tot[tid] = s; }
        __syncthreads();
#pragma unroll
        for (int t = 0; t < NT; ++t) {
            const float mean = tot[t] * (1.0f / 1024.0f), var = tot[NT + t] * (1.0f / 1024.0f) - mean * mean, rstd = 1.0f / sqrtf(fmaxf(var, 0.f) + EPS);
            const f32x2 a = (o[t] - mean) * rstd * lg + lb;
            *(unsigned*)(AACT + (size_t)(rowbase + t) * CA + c) = pk2(a.x * pg8::sigm(a.x), a.y * pg8::sigm(a.y));
        }
    }
}
__device__ __forceinline__ void mix_item(const Params& P, int layer, int item, LAS unsigned char* lds, int tid, int lane, int wave, bool dry = false, bool stats = true) {
    asm volatile("" : "+v"(tid), "+v"(lane));
    const int ck = item >> 3, g = item & 7, r0 = ck * 128;
    const bf16_t* V = (const bf16_t*)(P.ws + WS_V); bf16_t* U = (bf16_t*)(P.ws + WS_U); const float* vstat = (const float*)(P.ws + WS_VST);
    LAS float* st = (LAS float*)(lds + 4096); LAS bf16_t* vT = (LAS bf16_t*)(lds + 8192);
    constexpr int VP = 136;
    const int fr = lane & 15, fq = lane >> 4, t = 16 * wave + fr, nks = (wave >> 1) + 1;
    const float* wrow = P.in[15] + ((size_t)(layer * 8 + g) * 128 + t) * 128;
    f32x4 vs[12];
    if (stats && tid < 128) { const f32x4* p = (const f32x4*)(vstat + (size_t)(r0 + tid) * 48);
#pragma unroll
        for (int j = 0; j < 12; ++j) vs[j] = p[j]; }
    f32x4 wa[4], wb[4];
#pragma unroll
    for (int ks = 0; ks < 4; ++ks) if (ks < nks) { wa[ks] = *(const f32x4*)(wrow + 32 * ks + 8 * fq); wb[ks] = *(const f32x4*)(wrow + 32 * ks + 8 * fq + 4); }
    pg8::u32x2 uw[12];
#pragma unroll
    for (int cb = 0; cb < 12; ++cb) uw[cb] = *(const pg8::u32x2*)(U + (size_t)(r0 + t) * CB + g * 192 + 16 * cb + 4 * fq);
    const float bs = P.in[16][(layer * 8 + g) * 128 + t];
    const int q = tid >> 4, sp0 = tid & 15, ch = g * 192 + 8 * q;
    u32x4 va[4], vb[4]; f32x4 g0, g1, b0, b1;
    if (tid < 384) {
        g0 = *(const f32x4*)(P.in[13] + layer * CB + ch); g1 = *(const f32x4*)(P.in[13] + layer * CB + ch + 4);
        b0 = *(const f32x4*)(P.in[14] + layer * CB + ch); b1 = *(const f32x4*)(P.in[14] + layer * CB + ch + 4);
#pragma unroll
        for (int j = 0; j < 4; ++j) { const int s = 2 * (sp0 + 16 * j); va[j] = *(const u32x4*)(V + (size_t)(r0 + s) * CB + ch); vb[j] = *(const u32x4*)(V + (size_t)(r0 + s + 1) * CB + ch); } }
    __builtin_amdgcn_sched_barrier(0);
    if (stats && tid < 128) { float s1 = 0.f, s2 = 0.f;
#pragma unroll
        for (int j = 0; j < 12; ++j) { const f32x4 a = vs[j]; s1 += a[0] + a[2]; s2 += a[1] + a[3]; }
        const float mean = s1 * (1.0f / 1536.0f), var = s2 * (1.0f / 1536.0f) - mean * mean;
        st[2 * tid] = mean; st[2 * tid + 1] = 1.0f / sqrtf(fmaxf(var, 0.f) + EPS); }
    __syncthreads();
    const bool wr_v = (ck & 15) == 15; const int seq = ck >> 4;
    if (tid < 384) {
#pragma unroll
        for (int j = 0; j < 4; ++j) { const int s = 2 * (sp0 + 16 * j);
            f32x4 a0, a1, c0, c1; pg8::unpack8(va[j], a0, a1); pg8::unpack8(vb[j], c0, c1);
            const float m0 = st[2 * s], r0s = st[2 * s + 1], m1 = st[2 * s + 2], r1s = st[2 * s + 3];
            a0 = (a0 - m0) * r0s * g0 + b0; a1 = (a1 - m0) * r0s * g1 + b1; c0 = (c0 - m1) * r1s * g0 + b0; c1 = (c1 - m1) * r1s * g1 + b1;
            if (wr_v) { float* o = P.out + O_VP + ((size_t)(layer * 8 + seq) * 128 + s) * CB + ch; *(f32x4*)o = a0; *(f32x4*)(o + 4) = a1; *(f32x4*)(o + CB) = c0; *(f32x4*)(o + CB + 4) = c1; }
            LAS unsigned* d = (LAS unsigned*)(vT + (8 * q) * VP + s);
#pragma unroll
            for (int i = 0; i < 4; ++i) { d[i * (VP / 2)] = pk2(a0[i], c0[i]); d[(4 + i) * (VP / 2)] = pk2(a1[i], c1[i]); } }
    }
    __syncthreads();
    {
        f32x4 acc[12];
#pragma unroll
        for (int cb = 0; cb < 12; ++cb) acc[cb] = (f32x4){0.f, 0.f, 0.f, 0.f};
#pragma unroll
        for (int ks = 0; ks < 4; ++ks) if (ks < nks) { const int s0 = 32 * ks + 8 * fq;
            f32x4 xa = wa[ks], xb = wb[ks];
#pragma unroll
            for (int i = 0; i < 4; ++i) { if (s0 + i > t) xa[i] = 0.f; if (s0 + 4 + i > t) xb[i] = 0.f; }
            const u32x4 wp = pg8::pack8(xa, xb); const bf16x8 bfrag = __builtin_bit_cast(bf16x8, wp);
#pragma unroll
            for (int cb = 0; cb < 12; ++cb) { const bf16x8 afrag = *(const LAS bf16x8*)(vT + (16 * cb + fr) * VP + s0);
                acc[cb] = __builtin_amdgcn_mfma_f32_16x16x32_bf16(afrag, bfrag, acc[cb], 0, 0, 0); } }
#pragma unroll
        for (int cb = 0; cb < 12; ++cb) { bf16_t* up = U + (size_t)(r0 + t) * CB + g * 192 + 16 * cb + 4 * fq;
            const float m0 = (acc[cb][0] + bs) * pg8::bf_lo(uw[cb].x), m1 = (acc[cb][1] + bs) * pg8::bf_hi(uw[cb].x), m2 = (acc[cb][2] + bs) * pg8::bf_lo(uw[cb].y), m3 = (acc[cb][3] + bs) * pg8::bf_hi(uw[cb].y);
            if (!dry) *(pg8::u32x2*)up = (pg8::u32x2){pk2(m0, m1), pk2(m2, m3)}; else asm volatile("" :: "v"(m0 + m1 + m2 + m3)); }
    }
    __syncthreads();
}
__device__ __forceinline__ void mix_sample_item(const Params& P, int layer, int b, LAS unsigned char* lds, int tid) {
    const bf16_t* V = (const bf16_t*)(P.ws + WS_V); bf16_t* U = (bf16_t*)(P.ws + WS_U); const float* vstat = (const float*)(P.ws + WS_VST);
    LAS float* st = (LAS float*)(lds + 4096);
    asm volatile("" : "+v"(tid));
    const int r0 = MP + 4 * b;
    unsigned short vr[3][4], ur[3][4]; float lg[3], lb[3], wm[3][10], bsv[3][4];
#pragma unroll
    for (int j = 0; j < 3; ++j) { const int c = tid + 512 * j, g = c / 192;
        lg[j] = P.in[13][layer * CB + c]; lb[j] = P.in[14][layer * CB + c];
        const float* wg = P.in[15] + (size_t)(layer * 8 + g) * 128 * 128;
#pragma unroll
        for (int s = 0; s < 4; ++s) { vr[j][s] = V[(size_t)(r0 + s) * CB + c]; ur[j][s] = U[(size_t)(r0 + s) * CB + c]; bsv[j][s] = P.in[16][(layer * 8 + g) * 128 + s]; }
        int k = 0;
#pragma unroll
        for (int t = 0; t < 4; ++t)
#pragma unroll
            for (int s = 0; s <= t; ++s) wm[j][k++] = wg[t * 128 + s]; }
    if (tid < 4) { const f32x4* p = (const f32x4*)(vstat + (size_t)(r0 + tid) * 48); float s1 = 0.f, s2 = 0.f;
#pragma unroll
        for (int j = 0; j < 12; ++j) { const f32x4 a = p[j]; s1 += a[0] + a[2]; s2 += a[1] + a[3]; }
        const float mean = s1 * (1.0f / 1536.0f), var = s2 * (1.0f / 1536.0f) - mean * mean;
        st[2 * tid] = mean; st[2 * tid + 1] = 1.0f / sqrtf(fmaxf(var, 0.f) + EPS); }
    __syncthreads();
    __builtin_amdgcn_sched_barrier(0);
    float vl[3][4]; unsigned short ob[3][4];
#pragma unroll
    for (int j = 0; j < 3; ++j) {
#pragma unroll
        for (int s = 0; s < 4; ++s) vl[j][s] = (__uint_as_float((unsigned)vr[j][s] << 16) - st[2 * s]) * st[2 * s + 1] * lg[j] + lb[j];
        int k = 0;
#pragma unroll
        for (int t = 0; t < 4; ++t) { float m = bsv[j][t];
#pragma unroll
            for (int s = 0; s <= t; ++s) m += wm[j][k++] * vl[j][s];
            ob[j][t] = (unsigned short)(pk2(__uint_as_float((unsigned)ur[j][t] << 16) * m, 0.f) & 0xffffu); } }
    __builtin_amdgcn_sched_barrier(0);
#pragma unroll
    for (int j = 0; j < 3; ++j) { const int c = tid + 512 * j;
#pragma unroll
        for (int s = 0; s < 4; ++s) { P.out[O_VS + ((size_t)(layer * 128 + b) * 4 + s) * CB + c] = vl[j][s]; U[(size_t)(r0 + s) * CB + c] = ob[j][s]; } }
    __syncthreads();
}

#define XB_TMO      128
#define XB_XCNT(j)  (256  + 64 * (j))
#define XB_XSUB(j)  (1280 + 64 * (j))
#define XB_XGEN(j)  (2304 + 64 * (j))
#define XB_TOP      3328
#define XB_TOPGEN   3392
#define XCD_BAR_WORDS 3456
#define XB_SPIN_CAP (1u << 18)

__device__ __forceinline__ unsigned xb_ld(unsigned* p)              { return __hip_atomic_load(p, __ATOMIC_RELAXED, __HIP_MEMORY_SCOPE_AGENT); }
__device__ __forceinline__ unsigned xb_add(unsigned* p, unsigned v) { return __hip_atomic_fetch_add(p, v, __ATOMIC_RELAXED, __HIP_MEMORY_SCOPE_AGENT); }
__device__ __forceinline__ unsigned xb_xcc_id() { return (unsigned)__builtin_amdgcn_s_getreg((3 << 11) | 20) & 0xFu; }
#define XB_SPIN(cond, bar) do { unsigned _sp = 0; while (cond) { __builtin_amdgcn_s_sleep(1); \
    if ((++_sp & 255u) == 0u) { if (xb_ld(&(bar)[XB_TMO])) break; if (_sp > XB_SPIN_CAP) { atomicAdd(&(bar)[XB_TMO], 1u); break; } } } } while (0)

struct XcdBarrier {
    int wv;
    unsigned* bar; unsigned x;
    volatile LAS unsigned* st;
};

__device__ __forceinline__ XcdBarrier xcd_barrier_post(unsigned* bar, volatile LAS unsigned* st, int wv) {
    XcdBarrier b; b.wv = wv; b.bar = bar; b.x = xb_xcc_id(); b.st = st;
    if (wv == 0 && pg8::lane_now() == 0) (void)xb_add(&bar[XB_XCNT(b.x)], 1u);
    return b;
}
__device__ __forceinline__ void xcd_barrier_complete(unsigned* bar, unsigned x, unsigned& nloc, unsigned& nx) {
    const unsigned G = gridDim.x * gridDim.y * gridDim.z;
    unsigned sum, cnt, mine, sp = 0u;
    for (;;) {
        sum = 0u; cnt = 0u; mine = 0u;
#pragma unroll
        for (unsigned j = 0; j < 16; ++j) { const unsigned c = xb_ld(&bar[XB_XCNT(j)]); sum += c; cnt += (c > 0u) ? 1u : 0u; mine = (j == x) ? c : mine; }
        if (sum == G) break;
        __builtin_amdgcn_s_sleep(1);
        if ((++sp & 255u) == 0u) { if (xb_ld(&bar[XB_TMO])) break; if (sp > XB_SPIN_CAP) { atomicAdd(&bar[XB_TMO], 1u); break; } }
    }
    nloc = mine > 0u ? mine : 1u; nx = cnt > 0u ? cnt : 1u;
}

__device__ __forceinline__ void xcd_barrier(const XcdBarrier& b) {
    asm volatile("s_waitcnt vmcnt(0)" ::: "memory");
    __syncthreads();
    if (b.wv == 0 && pg8::lane_now() == 0) {
        unsigned* bar = b.bar;
        __builtin_amdgcn_s_waitcnt(0);
        unsigned nloc = b.st[0], nx = b.st[1];
        if (nloc == 0u) { xcd_barrier_complete(bar, b.x, nloc, nx); b.st[0] = nloc; b.st[1] = nx; }
        const unsigned old = xb_add(&bar[XB_XSUB(b.x)], 1u);
        const unsigned gen = old / nloc;
        if (old + 1u == (gen + 1u) * nloc) {
            __builtin_amdgcn_fence(__ATOMIC_RELEASE, "agent");
            asm volatile("s_waitcnt vmcnt(0)" ::: "memory");
            const unsigned og = xb_add(&bar[XB_TOP], 1u);
            const unsigned tg = og / nx;
            if (og + 1u == (tg + 1u) * nx) xb_add(&bar[XB_TOPGEN], 1u);
            else XB_SPIN(xb_ld(&bar[XB_TOPGEN]) == tg, bar);
            __builtin_amdgcn_fence(__ATOMIC_ACQUIRE, "agent");
            xb_add(&bar[XB_XGEN(b.x)], 1u);
            asm volatile("s_waitcnt vmcnt(0)" ::: "memory");
        } else {
            XB_SPIN(xb_ld(&bar[XB_XGEN(b.x)]) == gen, bar);
            __builtin_amdgcn_fence(__ATOMIC_ACQUIRE, "agent");
            asm volatile("s_waitcnt vmcnt(0)" ::: "memory");
        }
    }
    __syncthreads();
}

template <class Epi, bool NORED = false> __device__ __forceinline__ void gemm_mini(LAS unsigned char* lds, const bf16_t* A, const bf16_t* Bt, int N, int K, const Epi& E, int wave) {
    const int lane = pg8::lane_now(), fr = lane & 15, fq = lane >> 4;
    const int nmini = (N >> 8) * 16, G = gridDim.x, kw = K >> 3;
    for (int j = blockIdx.x; j < nmini; j += G) {
        const int wc = j & 3, wr = (j >> 2) & 1, pm = 64 + ((j >> 3) & 1), pn = j >> 4;
        f32x4 acc[2][2][4][2];
#pragma unroll
        for (int a = 0; a < 2; ++a)
#pragma unroll
            for (int b = 0; b < 2; ++b)
#pragma unroll
                for (int m = 0; m < 4; ++m)
#pragma unroll
                    for (int n = 0; n < 2; ++n) acc[a][b][m][n] = (f32x4){0.f, 0.f, 0.f, 0.f};
        const char* abase = (const char*)A + ((size_t)(pm * 256 + wr * 64) * K + (size_t)wave * kw) * 2;
        const char* bbase = (const char*)Bt + ((size_t)(pn * 256 + wc * 32) * K + (size_t)wave * kw) * 2;
        unsigned aoff = (unsigned)(fr * K + 8 * fq) * 2u, boff = (unsigned)((8 * (fr >> 2) + (fr & 3)) * K + 8 * fq) * 2u;
#pragma unroll 1
        for (int k0 = 0; k0 < kw; k0 += 32) {
            typedef const __attribute__((address_space(1))) bf16x8* gfrag_t;
            bf16x8 af[2][4], bf[2][2];
#pragma unroll
            for (int a = 0; a < 2; ++a)
#pragma unroll
                for (int m = 0; m < 4; ++m) af[a][m] = *(gfrag_t)(abase + (size_t)(a * 128 + m * 16) * K * 2 + aoff);
#pragma unroll
            for (int b = 0; b < 2; ++b)
#pragma unroll
                for (int n = 0; n < 2; ++n) bf[b][n] = *(gfrag_t)(bbase + (size_t)(b * 128 + 4 * n) * K * 2 + boff);
            __builtin_amdgcn_sched_barrier(0);
#pragma unroll
            for (int a = 0; a < 2; ++a)
#pragma unroll
                for (int b = 0; b < 2; ++b)
#pragma unroll
                    for (int m = 0; m < 4; ++m)
#pragma unroll
                        for (int n = 0; n < 2; ++n) acc[a][b][m][n] = __builtin_amdgcn_mfma_f32_16x16x32_bf16(bf[b][n], af[a][m], acc[a][b][m][n], 0, 0, 0);
            __builtin_amdgcn_sched_barrier(0);
            aoff += 64u; boff += 64u;
        }
#define MINI_IDX(a, b, m, n) (((((a) * 2 + (b)) * 4 + (m)) * 2 + (n)) * 1024)
#pragma unroll
        for (int half = NORED ? 0 : 4; half >= 1; half >>= 1) {
            if (wave >= half && wave < 2 * half) { const unsigned sa = (unsigned)(wave - half) * 32768u + (unsigned)lane * 16u;
#pragma unroll
                for (int a = 0; a < 2; ++a)
#pragma unroll
                    for (int b = 0; b < 2; ++b)
#pragma unroll
                        for (int m = 0; m < 4; ++m)
#pragma unroll
                            for (int n = 0; n < 2; ++n) asm volatile("ds_write_b128 %0, %1 offset:%2" :: "v"(sa), "v"(acc[a][b][m][n]), "n"(MINI_IDX(a, b, m, n)) : "memory");
                asm volatile("s_waitcnt lgkmcnt(0)" ::: "memory"); }
            __syncthreads();
            if (wave < half) { const unsigned sa = (unsigned)wave * 32768u + (unsigned)lane * 16u;
#pragma unroll
                for (int a = 0; a < 2; ++a)
#pragma unroll
                    for (int b = 0; b < 2; ++b) { f32x4 t0, t1, t2, t3, t4, t5, t6, t7;
                        asm volatile("ds_read_b128 %0, %8 offset:%9\n\tds_read_b128 %1, %8 offset:%10\n\tds_read_b128 %2, %8 offset:%11\n\tds_read_b128 %3, %8 offset:%12\n\t"
                                     "ds_read_b128 %4, %8 offset:%13\n\tds_read_b128 %5, %8 offset:%14\n\tds_read_b128 %6, %8 offset:%15\n\tds_read_b128 %7, %8 offset:%16\n\ts_waitcnt lgkmcnt(0)"
                                     : "=&v"(t0), "=&v"(t1), "=&v"(t2), "=&v"(t3), "=&v"(t4), "=&v"(t5), "=&v"(t6), "=&v"(t7)
                                     : "v"(sa), "n"(MINI_IDX(a, b, 0, 0)), "n"(MINI_IDX(a, b, 0, 1)), "n"(MINI_IDX(a, b, 1, 0)), "n"(MINI_IDX(a, b, 1, 1)),
                                       "n"(MINI_IDX(a, b, 2, 0)), "n"(MINI_IDX(a, b, 2, 1)), "n"(MINI_IDX(a, b, 3, 0)), "n"(MINI_IDX(a, b, 3, 1)) : "memory");
                        acc[a][b][0][0] += t0; acc[a][b][0][1] += t1; acc[a][b][1][0] += t2; acc[a][b][1][1] += t3;
                        acc[a][b][2][0] += t4; acc[a][b][2][1] += t5; acc[a][b][3][0] += t6; acc[a][b][3][1] += t7; } }
            __syncthreads();
        }
#undef MINI_IDX
        if (wave == 0) { pg8::Unit u{pm, pn}; E(acc, u, wr, wc, fr, fq); }
    }
}
template <class Epi, int AI, int MH2> __device__ __forceinline__ void mini32_unit(LAS unsigned char* lds, const char* abase, const char* bbase, int K, int kw, const Epi& E, int wave, int lane, int pm, int pn, int wr, int wc) {
    typedef const __attribute__((address_space(1))) bf16x8* gfrag_t;
    const int fr = lane & 15, fq = lane >> 4;
    f32x4 acc[2][2][4][2];
#pragma unroll
    for (int b = 0; b < 2; ++b)
#pragma unroll
        for (int mm = 0; mm < 2; ++mm)
#pragma unroll
            for (int n = 0; n < 2; ++n) acc[AI][b][2 * MH2 + mm][n] = (f32x4){0.f, 0.f, 0.f, 0.f};
    unsigned aoff = (unsigned)(fr * K + 8 * fq) * 2u, boff = (unsigned)((8 * (fr >> 2) + (fr & 3)) * K + 8 * fq) * 2u;
#pragma unroll 1
    for (int k0 = 0; k0 < kw; k0 += 32) {
        bf16x8 af[2], bf[2][2];
#pragma unroll
        for (int mm = 0; mm < 2; ++mm) af[mm] = *(gfrag_t)(abase + (size_t)(AI * 128 + (2 * MH2 + mm) * 16) * K * 2 + aoff);
#pragma unroll
        for (int b = 0; b < 2; ++b)
#pragma unroll
            for (int n = 0; n < 2; ++n) bf[b][n] = *(gfrag_t)(bbase + (size_t)(b * 128 + 4 * n) * K * 2 + boff);
        __builtin_amdgcn_sched_barrier(0);
#pragma unroll
        for (int b = 0; b < 2; ++b)
#pragma unroll
            for (int mm = 0; mm < 2; ++mm)
#pragma unroll
                for (int n = 0; n < 2; ++n) acc[AI][b][2 * MH2 + mm][n] = __builtin_amdgcn_mfma_f32_16x16x32_bf16(bf[b][n], af[mm], acc[AI][b][2 * MH2 + mm][n], 0, 0, 0);
        __builtin_amdgcn_sched_barrier(0);
        aoff += 64u; boff += 64u;
    }
#define M32_IDX(b, mm, n) ((((b) * 2 + (mm)) * 2 + (n)) * 1024)
#pragma unroll
    for (int half = 4; half >= 1; half >>= 1) {
        if (wave >= half && wave < 2 * half) { const unsigned sa = (unsigned)(wave - half) * 8192u + (unsigned)lane * 16u;
#pragma unroll
            for (int b = 0; b < 2; ++b)
#pragma unroll
                for (int mm = 0; mm < 2; ++mm)
#pragma unroll
                    for (int n = 0; n < 2; ++n) asm volatile("ds_write_b128 %0, %1 offset:%2" :: "v"(sa), "v"(acc[AI][b][2 * MH2 + mm][n]), "n"(M32_IDX(b, mm, n)) : "memory");
            asm volatile("s_waitcnt lgkmcnt(0)" ::: "memory"); }
        __syncthreads();
        if (wave < half) { const unsigned sa = (unsigned)wave * 8192u + (unsigned)lane * 16u; f32x4 t0, t1, t2, t3, t4, t5, t6, t7;
            asm volatile("ds_read_b128 %0, %8 offset:%9\n\tds_read_b128 %1, %8 offset:%10\n\tds_read_b128 %2, %8 offset:%11\n\tds_read_b128 %3, %8 offset:%12\n\t"
                         "ds_read_b128 %4, %8 offset:%13\n\tds_read_b128 %5, %8 offset:%14\n\tds_read_b128 %6, %8 offset:%15\n\tds_read_b128 %7, %8 offset:%16\n\ts_waitcnt lgkmcnt(0)"
                         : "=&v"(t0), "=&v"(t1), "=&v"(t2), "=&v"(t3), "=&v"(t4), "=&v"(t5), "=&v"(t6), "=&v"(t7)
                         : "v"(sa), "n"(M32_IDX(0, 0, 0)), "n"(M32_IDX(0, 0, 1)), "n"(M32_IDX(0, 1, 0)), "n"(M32_IDX(0, 1, 1)),
                           "n"(M32_IDX(1, 0, 0)), "n"(M32_IDX(1, 0, 1)), "n"(M32_IDX(1, 1, 0)), "n"(M32_IDX(1, 1, 1)) : "memory");
            acc[AI][0][2 * MH2][0] += t0; acc[AI][0][2 * MH2][1] += t1; acc[AI][0][2 * MH2 + 1][0] += t2; acc[AI][0][2 * MH2 + 1][1] += t3;
            acc[AI][1][2 * MH2][0] += t4; acc[AI][1][2 * MH2][1] += t5; acc[AI][1][2 * MH2 + 1][0] += t6; acc[AI][1][2 * MH2 + 1][1] += t7; }
        __syncthreads();
    }
#undef M32_IDX
    if (wave == 0) { pg8::Unit u{pm, pn}; E.template operator()<AI, AI + 1, 2 * MH2, 2 * MH2 + 2>(acc, u, wr, wc, fr, fq); }
}
template <class Epi> __device__ __forceinline__ void gemm_mini64(LAS unsigned char* lds, const bf16_t* A, const bf16_t* Bt, int N, int K, const Epi& E, int wave) {
    const int lane = pg8::lane_now();
    const int nmini = (N >> 8) * 64, G = gridDim.x, kw = K >> 3;
    for (int j = blockIdx.x; j < nmini; j += G) {
        const int wc = j & 3, wr = (j >> 2) & 1, mh = (j >> 3) & 1, ai = (j >> 4) & 1, pm = 64 + ((j >> 5) & 1), pn = j >> 6;
        const char* abase = (const char*)A + ((size_t)(pm * 256 + wr * 64) * K + (size_t)wave * kw) * 2;
        const char* bbase = (const char*)Bt + ((size_t)(pn * 256 + wc * 32) * K + (size_t)wave * kw) * 2;
        if (ai == 0) { if (mh == 0) mini32_unit<Epi, 0, 0>(lds, abase, bbase, K, kw, E, wave, lane, pm, pn, wr, wc); else mini32_unit<Epi, 0, 1>(lds, abase, bbase, K, kw, E, wave, lane, pm, pn, wr, wc); }
        else { if (mh == 0) mini32_unit<Epi, 1, 0>(lds, abase, bbase, K, kw, E, wave, lane, pm, pn, wr, wc); else mini32_unit<Epi, 1, 1>(lds, abase, bbase, K, kw, E, wave, lane, pm, pn, wr, wc); }
    }
}
template <class Epi, bool SMALLN = false> __device__ __forceinline__ void run_gemm(LAS unsigned char* lds, const bf16_t* A, const bf16_t* Bt, int N, int K, const Epi& E, int wv) {
    asm volatile("" : "+s"(K)); asm volatile("" : "+s"(N));
    pg8::Gemm g{A, Bt, MP, N, K}; pg8::StaticOrder S; S.init(MP, N, (int)gridDim.x, (int)blockIdx.x);
    const bool mini_first = ((blockIdx.x >> 3) & 1) != 0;
#pragma unroll 1
    for (int pass = 0; pass < 2; ++pass) {
        if ((pass == 0) == mini_first) { if constexpr (SMALLN) gemm_mini64<Epi>(lds, A, Bt, N, K, E, wv); else gemm_mini<Epi>(lds, A, Bt, N, K, E, wv); }
        if (pass == 0) pg8::gemm_phase<Epi, pg8::StaticOrder, true, true>(lds, g, S, E, wv);
    }
#if (MK_PROBE & 1)
    { pg8::EpiNop EN; pg8::gemm_phase<pg8::EpiNop, pg8::StaticOrder, true, true>(lds, g, S, EN, wv); }
#endif
#if (MK_PROBE & 2)
    { pg8::EpiNop EN; gemm_mini<pg8::EpiNop, (MK_PROBE & 32) != 0>(lds, A, Bt, N, K, EN, wv); }
#endif
}

__global__ void __launch_bounds__(NTHR, 2) mega_fwd(Params P) {
    extern __shared__ __attribute__((aligned(16))) unsigned char lds_raw[];
    LAS unsigned char* lds = (LAS unsigned char*)lds_raw;
    cg::grid_group grid = cg::this_grid();
    const int lo = P.ph_lo, hi = P.ph_hi;
    volatile LAS unsigned* MISC = (volatile LAS unsigned*)(lds + LDS_BYTES - 128);
    int wv = __builtin_amdgcn_readfirstlane(threadIdx.x >> 6); asm volatile("" : "+s"(wv));
    if (wv == 0) { const int l0 = pg8::lane_now(); if (l0 < 32) MISC[l0] = 0u; }
    __syncthreads();
    XcdBarrier bar = xcd_barrier_post((unsigned*)(P.ws + WS_CTL), MISC + 8, wv);
#define IN(k) (lo <= (k) && (k) < hi)
#define SEAM(k) do { if (IN(k) && IN((k) + 1)) { if ((k) == 0) grid.sync(); else xcd_barrier(bar); } } while (0)
#define PHASE_PROLOGUE \
    unsigned char* ws = P.ws; asm volatile("" : "+s"(ws)); \
    const int lane = pg8::lane_now(), wave = wv, G = gridDim.x; int tid = wave * 64 + lane; \
    const int gw = blockIdx.x * NWAVES + wave, ngw = G * NWAVES; (void)tid; \
    bf16_t* XB = (bf16_t*)(ws + WS_XB); bf16_t* PB = (bf16_t*)(ws + WS_PB); bf16_t* U = (bf16_t*)(ws + WS_U); bf16_t* GLU = (bf16_t*)(ws + WS_GLU); bf16_t* V = (bf16_t*)(ws + WS_V); \
    bf16_t* H = (bf16_t*)(ws + WS_H); bf16_t* GA = (bf16_t*)(ws + WS_GA); bf16_t* GB = (bf16_t*)(ws + WS_GB); \
    float* SSA = (float*)(ws + WS_SSA); float* SSB = (float*)(ws + WS_SSB); float* VST = (float*)(ws + WS_VST); \
    (void)lane; (void)gw; (void)ngw; (void)XB; (void)PB; (void)U; (void)GLU; (void)V; (void)H; (void)GA; (void)GB; (void)SSA; (void)SSB; (void)VST; (void)G;

    if (IN(0)) { PHASE_PROLOGUE convert(P, 0, 0x3ffu, lds, gw, ngw, lane); x_to_bf16(P, gw, ngw, lane); }
    SEAM(0);
    for (int l = 0; l < 2; ++l) {
        const int pb = 1 + 7 * l;
        if (IN(pb + 0)) { PHASE_PROLOGUE
            pg8::EpiIn E0{(const float*)(ws + WS_BIN), SSA, GLU, U, V, GA, GB, VST, P.out, l};
#if (MK_PROBE & 16)
            pg8::EpiTwice<pg8::EpiIn> E{E0};
#else
            const pg8::EpiIn& E = E0;
#endif
            run_gemm(lds, XB, (const bf16_t*)(ws + WS_WIN), DIN, DM, E, wave);
            if (l == 1) convert(P, 1, 1u << 6, lds, gw, ngw, lane);
        }
        SEAM(pb + 0);
        if (IN(pb + 1)) { PHASE_PROLOGUE
            if (G == 256) {
                const int i0 = (blockIdx.x & 7) * 128 + (blockIdx.x >> 3) * 4;
                const bool conv_first = ((blockIdx.x >> 3) & 1) != 0;
                if (conv_first) conv_items<16, false>(P, l, lds, tid, lane, wave, i0, i0 + 4, 1);
                for (int k = 0; k < 4; ++k) mix_item(P, l, i0 + k, lds, tid, lane, wave, false, k == 0);
                if (!conv_first) conv_items<16, false>(P, l, lds, tid, lane, wave, i0, i0 + 4, 1);
            } else {
                for (int it = blockIdx.x; it < 1024; it += G) mix_item(P, l, it, lds, tid, lane, wave);
                const int ipc = (1024 + G - 1) / G, i0 = blockIdx.x * ipc;
                conv_items<16, false>(P, l, lds, tid, lane, wave, i0, (i0 + ipc < 1024 ? i0 + ipc : 1024), 1);
            }
            conv_items<4, true>(P, l, lds, tid, lane, wave, blockIdx.x, 128, G);
            for (int it = (blockIdx.x + G - (G >> 1)) % G; it < 128; it += G) mix_sample_item(P, l, it, lds, tid);
#if (MK_PROBE & 4)
            for (int it = blockIdx.x; it < 1024; it += G) mix_item(P, l, it, lds, tid, lane, wave, true);
            conv_items<16, false>(P, l, lds, tid, lane, wave, blockIdx.x, 1024, G);
            conv_items<4, true>(P, l, lds, tid, lane, wave, blockIdx.x, 128, G);
#endif
            if (l == 0) convert(P, 1, 1u | 256u, lds, gw, ngw, lane);
        }
        SEAM(pb + 1);
        if (IN(pb + 2)) { PHASE_PROLOGUE
            { pg8::EpiMul<0> E{GA, nullptr, nullptr, DM}; run_gemm<pg8::EpiMul<0>, true>(lds, (const bf16_t*)P.out, (const bf16_t*)(ws + WS_WA), DM, CA, E, wave); }
            { pg8::EpiMul<1> E{GB, GA, nullptr, DM}; run_gemm<pg8::EpiMul<1>, true>(lds, U, (const bf16_t*)(ws + WS_WB), DM, CB, E, wave); }
        }
        SEAM(pb + 2);
        if (IN(pb + 3)) { PHASE_PROLOGUE
            pg8::EpiRes<false> E{XB, XB, SSA, nullptr, nullptr, nullptr};
            run_gemm<pg8::EpiRes<false>, true>(lds, GB, (const bf16_t*)(ws + WS_WO), DM, DM, E, wave);
            if (l == 0) convert(P, 1, (1u << 1) | (1u << 2), lds, gw, ngw, lane);
        }
        SEAM(pb + 3);
        if (IN(pb + 4)) { PHASE_PROLOGUE
            { pg8::EpiMul<2> E{GA, nullptr, nullptr, DM}; run_gemm<pg8::EpiMul<2>, true>(lds, PB, (const bf16_t*)(ws + WS_WPE), DM, PDIM, E, wave); }
#if (MK_PROBE & 16)
            { pg8::EpiTwice<pg8::EpiMul<3>> E{{H, nullptr, SSA, DFF}}; run_gemm(lds, XB, (const bf16_t*)(ws + WS_W1), DFF, DM, E, wave); }
#else
            { pg8::EpiMul<3> E{H, nullptr, SSA, DFF}; run_gemm(lds, XB, (const bf16_t*)(ws + WS_W1), DFF, DM, E, wave); }
#endif
            if (l == 0) convert(P, 1, 1u << 3, lds, gw, ngw, lane);
        }
        SEAM(pb + 4);
        if (IN(pb + 5)) { PHASE_PROLOGUE
            pg8::EpiRes<false> E{XB, GB, SSB, nullptr, nullptr, nullptr};
            run_gemm<pg8::EpiRes<false>, true>(lds, H, (const bf16_t*)(ws + WS_W2), DM, DFF, E, wave);
            if (l == 0) convert(P, 1, (1u << 4) | (1u << 7) | 512u, lds, gw, ngw, lane);
        }
        SEAM(pb + 5);
        if (IN(pb + 6)) { PHASE_PROLOGUE
            pg8::EpiRes<true> E{GB, XB, SSA, SSB, P.in[25] + l * DM, GA};
            run_gemm<pg8::EpiRes<true>, true>(lds, GB, (const bf16_t*)(ws + WS_WPG), DM, DM, E, wave);
            if (l == 0) convert(P, 1, 1u << 5, lds, gw, ngw, lane);
        }
        SEAM(pb + 6);
    }
    if (IN(15)) { PHASE_PROLOGUE final_norm(P, gw, ngw, lane); }
#undef IN
#undef SEAM
#undef PHASE_PROLOGUE
}

#ifndef MK_PER_PHASE
#define MK_PER_PHASE 0
#endif
extern "C" void kernel_launch(void* const* d_in, const int* in_sizes, int n_in, void* d_out, int out_size, void* d_ws, size_t ws_size, hipStream_t stream) {
    static int grid = 0;
    if (grid == 0) {
        if (n_in != 27 || out_size != 30375936 || ws_size < WS_END) { fprintf(stderr, "kernel_launch: unexpected sizes n_in %d out %d ws %zu (need %zu)\n", n_in, out_size, ws_size, (size_t)WS_END); grid = -1; return; }
        int dev = 0, cus = 0, per_cu = 0;
        hipGetDevice(&dev); hipDeviceGetAttribute(&cus, hipDeviceAttributeMultiprocessorCount, dev);
        if (hipFuncSetAttribute((const void*)mega_fwd, hipFuncAttributeMaxDynamicSharedMemorySize, LDS_BYTES) != hipSuccess) { fprintf(stderr, "hipFuncSetAttribute failed\n"); grid = -1; return; }
        if (hipOccupancyMaxActiveBlocksPerMultiprocessor(&per_cu, (const void*)mega_fwd, NTHR, LDS_BYTES) != hipSuccess || per_cu < 1) { fprintf(stderr, "occupancy query: %d\n", per_cu); (void)hipGetLastError(); per_cu = 1; }
        grid = cus;
        fprintf(stderr, "kernel_launch: grid %d (per_cu %d), ws %zu need %zu\n", grid, per_cu, ws_size, (size_t)WS_END);
    }
    if (grid < 0) return;
    if (hipMemsetAsync((char*)d_ws + WS_CTL, 0, 65536, stream) != hipSuccess) { fprintf(stderr, "memset failed\n"); return; }
    Params p{};
    for (int i = 0; i < 27; ++i) p.in[i] = (const float*)d_in[i];
    p.out = (float*)d_out; p.ws = (unsigned char*)d_ws;
#if MK_PER_PHASE
    for (int k = 0; k < 16; ++k) { p.ph_lo = k; p.ph_hi = k + 1; hipLaunchKernelGGL(mega_fwd, dim3(grid), dim3(NTHR), LDS_BYTES, stream, p); }
#else
    p.ph_lo = 0; p.ph_hi = 16;
    void* args[] = {&p};
    hipError_t e = hipLaunchCooperativeKernel((const void*)mega_fwd, dim3(grid), dim3(NTHR), args, LDS_BYTES, stream);
    if (e != hipSuccess) fprintf(stderr, "cooperative launch failed: %s (grid %d)\n", hipGetErrorString(e), grid);
#endif
}
```
